# Optimizing an MI355X kernel written in HIP

```python
import jax
import jax.numpy as jnp
from jax import lax
import numpy as np

D_MODEL = 1024
BATCH = 8
SEQ = 2048
DEPTH = 4

CHUNK = 64
EPS = 1e-6

A_HEADS = 8
A_HEAD_DIM = 64
A_WIDTH = A_HEADS * A_HEAD_DIM
N_PREV_CHUNKS = 8
BAND = (N_PREV_CHUNKS + 1) * CHUNK
REL_CLIP = 128
N_REL = 2 * REL_CLIP + 1

B_HEADS = 4
B_KEY_DIM = 64
B_VAL_DIM = 128
B_KEY_WIDTH = B_HEADS * B_KEY_DIM
B_WIDTH = B_HEADS * B_VAL_DIM
GATE_RANK = 16
GATE_TAU = 16.0

N_BRANCH = 2
BRANCH_WIDTH = 512

D_FF = 4 * D_MODEL

IN_SPLITS = (A_WIDTH, A_WIDTH, A_WIDTH, B_KEY_WIDTH, B_KEY_WIDTH, B_WIDTH, B_WIDTH, GATE_RANK, D_MODEL, D_MODEL)
IN_COLS = 5136

kernel_name = "hybrid_bandattn_gla_gated_merge"


def rmsnorm(x, g):
    xf = x.astype(jnp.float32)
    y = xf * lax.rsqrt(jnp.mean(xf * xf, axis=-1, keepdims=True) + EPS)
    return (y * g.astype(jnp.float32)).astype(x.dtype)


def _rel_index():
    i = np.arange(CHUNK)[:, None]
    kk = np.arange(BAND)[None, :]
    dist = N_PREV_CHUNKS * CHUNK + i - kk
    return (np.clip(dist, -REL_CLIP, REL_CLIP) + REL_CLIP).astype(np.int32)


def band_attention(q, k, v, rel_bias):
    Bsz, S, H, Dh = q.shape
    n_c = S // CHUNK
    qc = q.reshape(Bsz, n_c, CHUNK, H, Dh)
    pad = ((0, 0), (N_PREV_CHUNKS, 0), (0, 0), (0, 0), (0, 0))
    kp = jnp.pad(k.reshape(Bsz, n_c, CHUNK, H, Dh), pad)
    vp = jnp.pad(v.reshape(Bsz, n_c, CHUNK, H, Dh), pad)
    band_idx = jnp.arange(n_c)[:, None] + jnp.arange(N_PREV_CHUNKS + 1)[None, :]
    kb = kp[:, band_idx].reshape(Bsz, n_c, BAND, H, Dh)
    vb = vp[:, band_idx].reshape(Bsz, n_c, BAND, H, Dh)
    s = jnp.einsum('bcqhd,bckhd->bhcqk', qc, kb).astype(jnp.float32) * (Dh ** -0.5)
    bias = rel_bias.astype(jnp.float32)[:, _rel_index()]
    s = s + bias[:, None, :, :]
    key_chunk = jnp.arange(n_c)[:, None] - N_PREV_CHUNKS + (jnp.arange(BAND) // CHUNK)[None, :]
    valid = key_chunk >= 0
    s = jnp.where(valid[None, None, :, None, :], s, -1e30)
    p = jax.nn.softmax(s, axis=-1).astype(v.dtype)
    o = jnp.einsum('bhcqk,bckhd->bcqhd', p, vb)
    return o.reshape(Bsz, S, H * Dh)


def gla(q, k, v, log_a):
    f32 = jnp.float32
    Bsz, S, H, Dk = q.shape
    Dv = v.shape[-1]
    n_c = S // CHUNK
    qc = q.reshape(Bsz, n_c, CHUNK, H, Dk).astype(f32) * (Dk ** -0.5)
    kc = k.reshape(Bsz, n_c, CHUNK, H, Dk).astype(f32)
    vc = v.reshape(Bsz, n_c, CHUNK, H, Dv).astype(f32)
    b = jnp.cumsum(log_a.reshape(Bsz, n_c, CHUNK, H, Dk).astype(f32), axis=2)
    b_last = b[:, :, -1]
    q_t = qc * jnp.exp(b)
    k_t = kc * jnp.exp(-b)
    k_end = kc * jnp.exp(b_last[:, :, None] - b)
    att = jnp.einsum('bcihd,bcjhd->bchij', q_t, k_t)
    causal = jnp.tril(jnp.ones((CHUNK, CHUNK), dtype=bool))
    att = jnp.where(causal, att, 0.0)
    o_intra = jnp.einsum('bchij,bcjhv->bcihv', att, vc)
    d_state = jnp.einsum('bcjhd,bcjhv->bchdv', k_end, vc)

    def step(state, inp):
        ds_c, decay_c = inp
        return decay_c[..., None] * state + ds_c, state

    s0 = jnp.zeros((Bsz, H, Dk, Dv), f32)
    _, s_prev = lax.scan(step, s0, (jnp.swapaxes(d_state, 0, 1), jnp.swapaxes(jnp.exp(b_last), 0, 1)))
    s_prev = jnp.swapaxes(s_prev, 0, 1)
    o_inter = jnp.einsum('bcihd,bchdv->bcihv', q_t, s_prev)
    return (o_intra + o_inter).reshape(Bsz, S, H, Dv)


def hybrid_mixer(h, w_in, rel_bias, w_gate_lr, b_gate, gla_norm_g, w_branch, w_out):
    Bsz, S, _ = h.shape
    proj = h @ w_in
    split_at = np.cumsum(np.array(IN_SPLITS))[:-1].tolist()
    qa, ka, va, qb, kb, vb, rb, lrb, ga, gb = jnp.split(proj, split_at, axis=-1)
    y_a = band_attention(qa.reshape(Bsz, S, A_HEADS, A_HEAD_DIM),
                         ka.reshape(Bsz, S, A_HEADS, A_HEAD_DIM),
                         va.reshape(Bsz, S, A_HEADS, A_HEAD_DIM), rel_bias)
    log_a = jax.nn.log_sigmoid((lrb @ w_gate_lr + b_gate).astype(jnp.float32)) / GATE_TAU
    o_b = gla(qb.reshape(Bsz, S, B_HEADS, B_KEY_DIM),
              kb.reshape(Bsz, S, B_HEADS, B_KEY_DIM),
              vb.reshape(Bsz, S, B_HEADS, B_VAL_DIM),
              log_a.reshape(Bsz, S, B_HEADS, B_KEY_DIM))
    o_b = o_b * lax.rsqrt(jnp.mean(o_b * o_b, axis=-1, keepdims=True) + EPS)
    o_b = o_b * gla_norm_g.astype(jnp.float32).reshape(B_HEADS, B_VAL_DIM)
    y_b = (o_b.reshape(Bsz, S, B_WIDTH) * jax.nn.silu(rb.astype(jnp.float32))).astype(h.dtype)
    u_a = y_a @ w_branch[0]
    u_b = y_b @ w_branch[1]
    merged = jax.nn.sigmoid(ga) * u_a + jax.nn.sigmoid(gb) * u_b
    return merged @ w_out


def sqrelu_mlp(h, w_up, w_down):
    return jnp.square(jax.nn.relu(h @ w_up)) @ w_down


def setup_inputs(seed: int = 0) -> dict:
    key = jax.random.key(seed)
    ks = jax.random.split(key, 13)

    def nrm(k, shape, scale):
        return scale * jax.random.normal(k, shape, jnp.float32)

    return {
        "x": nrm(ks[0], (BATCH, SEQ, D_MODEL), 1.0),
        "mix_norm_g": 1.0 + nrm(ks[1], (DEPTH, D_MODEL), 0.02),
        "w_in": nrm(ks[2], (DEPTH, D_MODEL, IN_COLS), D_MODEL ** -0.5),
        "rel_bias": nrm(ks[3], (DEPTH, A_HEADS, N_REL), 0.1),
        "w_gate_lr": nrm(ks[4], (DEPTH, GATE_RANK, B_KEY_WIDTH), GATE_RANK ** -0.5),
        "b_gate": nrm(ks[5], (DEPTH, B_KEY_WIDTH), 0.5),
        "gla_norm_g": 1.0 + nrm(ks[6], (DEPTH, B_WIDTH), 0.02),
        "w_branch": nrm(ks[7], (DEPTH, N_BRANCH, BRANCH_WIDTH, D_MODEL), BRANCH_WIDTH ** -0.5),
        "w_out": nrm(ks[8], (DEPTH, D_MODEL, D_MODEL), D_MODEL ** -0.5),
        "mlp_norm_g": 1.0 + nrm(ks[9], (DEPTH, D_MODEL), 0.02),
        "w_up": nrm(ks[10], (DEPTH, D_MODEL, D_FF), D_MODEL ** -0.5),
        "w_down": nrm(ks[11], (DEPTH, D_FF, D_MODEL), D_FF ** -0.5),
        "final_norm_g": 1.0 + nrm(ks[12], (D_MODEL,), 0.02),
    }


def reference(x, mix_norm_g, w_in, rel_bias, w_gate_lr, b_gate, gla_norm_g, w_branch, w_out,
              mlp_norm_g, w_up, w_down, final_norm_g):
    res = x
    for l in range(DEPTH):
        h = rmsnorm(res, mix_norm_g[l])
        res = res + hybrid_mixer(h, w_in[l], rel_bias[l], w_gate_lr[l], b_gate[l], gla_norm_g[l],
                                 w_branch[l], w_out[l])
        h = rmsnorm(res, mlp_norm_g[l])
        res = res + sqrelu_mlp(h, w_up[l], w_down[l])
    return rmsnorm(res, final_norm_g)
```

```cpp
#include <hip/hip_runtime.h>
#include <cstdio>
#include <cstdint>
#ifndef CFG_BATCH
#define CFG_BATCH 8
#endif
#ifndef CFG_SEQ
#define CFG_SEQ 2048
#endif
constexpr int BATCH = CFG_BATCH, SEQ = CFG_SEQ, DM = 1024, DEPTH = 4, NCH = SEQ / 64, M = BATCH * SEQ;
constexpr int O_QA = 0, O_VB = O_QA + 256 * 512, O_KA = O_VB + 256 * 512, O_VA = O_KA + 256 * 512, O_QB = O_VA + 256 * 512, O_KB = O_QB + 256 * 256, O_RB = O_KB + 256 * 256, O_LA = O_RB + 256 * 512,
              O_GA = O_LA + 256 * 512  , O_GB = O_GA + 256 * 1024, PBE = O_GB + 256 * 1024;
constexpr int LDH = 4096 + 64;
constexpr int NREL = 257, DFF = 4096, INC = 5136, NIN = 5120;
constexpr int NITEM = BATCH * NCH * 4;
constexpr float EPS = 1e-6f, LOG2E = 1.4426950408889634f, LN2 = 0.6931471805599453f;
constexpr int NW = 8, NT = 512;

typedef unsigned short bf16_t;
typedef unsigned u32x2 __attribute__((ext_vector_type(2)));
typedef unsigned u32x4 __attribute__((ext_vector_type(4)));
typedef float f32x2 __attribute__((ext_vector_type(2)));

#ifdef EMU
#define DEV inline
#define LAS
#define MFMA32(a, b, c) emu_mfma32(a, b, c)
#define MFMA16(a, b, c) emu_mfma16(a, b, c)
#define SHFL_XOR(v, m) emu_shfl_xor(v, m)
#define TR_READ(p) emu_tr_read((const void*)(p))
#define WAVE_LDS_SYNC() emu::wave_sync()
#define EXP2F(x) exp2f(x)
#define LOG2F(x) log2f(x)
#define RCPF(x) (1.0f / (x))
#define RSQF(x) (1.0f / sqrtf(x))
#define ATOMIC_ADD_U64(p, v) (*(p) += (v))
#define OPAQUE_V(x)
#define OPAQUE_S(x)
#define SCHED_FENCE()
#define BPERM(srclane, v) emu_shfl((v), (srclane))
#define DPP_SHR_F(v, n) emu_row_shr((v), (n))
#define ADD_INPLACE(x, y) ((x) += (y))
#define WAVE_ANY(c) emu_wave_any(c)
#define ST16_WT(p, v) (*(u32x4*)(p) = (v))
DEV unsigned cvtpk(float lo, float hi) { auto f = [](float x) { unsigned u; memcpy(&u, &x, 4); return (u + 0x7fffu + ((u >> 16) & 1u)) >> 16; }; return f(lo) | (f(hi) << 16); }
#else
#define DEV __device__ __forceinline__
#define LAS __attribute__((address_space(3)))
typedef short bf16x8 __attribute__((ext_vector_type(8)));
typedef short s16x4 __attribute__((ext_vector_type(4)));
typedef float f32x16 __attribute__((ext_vector_type(16)));
typedef float f32x4 __attribute__((ext_vector_type(4)));
typedef short v4i16_t __attribute__((ext_vector_type(4)));
typedef __bf16 bf16x2_t __attribute__((ext_vector_type(2)));
#define MFMA32(a, b, c) __builtin_amdgcn_mfma_f32_32x32x16_bf16(a, b, c, 0, 0, 0)
#define MFMA16(a, b, c) __builtin_amdgcn_mfma_f32_16x16x32_bf16(a, b, c, 0, 0, 0)
#define SHFL_XOR(v, m) __shfl_xor(v, m)
#define TR_READ(p) __builtin_bit_cast(s16x4, __builtin_amdgcn_ds_read_tr16_b64_v4i16((LAS v4i16_t*)(p)))
#define WAVE_LDS_SYNC() asm volatile("s_waitcnt lgkmcnt(0)" ::: "memory")
#define EXP2F(x) __builtin_amdgcn_exp2f(x)
#define LOG2F(x) __builtin_amdgcn_logf(x)
#define RCPF(x) __builtin_amdgcn_rcpf(x)
#define RSQF(x) __builtin_amdgcn_rsqf(x)
#define ATOMIC_ADD_U64(p, v) atomicAdd((p), (v))
#define OPAQUE_V(x) asm volatile("" : "+v"(x))
#define OPAQUE_S(x) asm volatile("" : "+s"(x))
#define BPERM(srclane, v) ((unsigned)__builtin_amdgcn_ds_bpermute((srclane) * 4, (int)(v)))
#define DPP_SHR_F(v, n) __builtin_bit_cast(float, __builtin_amdgcn_update_dpp(0, __builtin_bit_cast(int, (float)(v)), 0x110 + (n), 0xf, 0xf, true))
#define ADD_INPLACE(x, y) asm("v_add_f32_e32 %0, %1, %0" : "+v"(x) : "v"(y))
#define WAVE_ANY(c) (__builtin_amdgcn_ballot_w64(c) != 0ull)
#define SCHED_FENCE() __builtin_amdgcn_sched_barrier(0)
#define ST16_WT(p, v) (*(u32x4*)(p) = (v))
DEV unsigned cvtpk(float lo, float hi) { f32x2 v = {lo, hi}; bf16x2_t b = __builtin_convertvector(v, bf16x2_t); return __builtin_bit_cast(unsigned, b); }
#endif
typedef LAS unsigned char* lds_t;
DEV size_t pofs(size_t row, int ld) { return (row >> 8) * (size_t)PBE + (row & 255) * (size_t)ld; }
DEV size_t pofs_f(size_t row, int ld) { return (row >> 8) * (size_t)(PBE / 2) + (row & 255) * (size_t)ld; }

DEV float bf2f(bf16_t b) { return __builtin_bit_cast(float, (unsigned)b << 16); }
DEV float bflo(unsigned u) { return __builtin_bit_cast(float, u << 16); }
DEV float bfhi(unsigned u) { return __builtin_bit_cast(float, u & 0xffff0000u); }
DEV int crow(int r, int hi) { return (r & 3) + 8 * (r >> 2) + 4 * hi; }
constexpr float SSQ_SCALE = 16777216.0f, SSQ_INV = 1.0f / 16777216.0f;
DEV float ssq_rstd(unsigned long long v) { return RSQF((float)v * (SSQ_INV / DM) + EPS); }
DEV u32x4 pack8(const f32x4 a, const f32x4 b) { u32x4 w; w[0] = cvtpk(a[0], a[1]); w[1] = cvtpk(a[2], a[3]); w[2] = cvtpk(b[0], b[1]); w[3] = cvtpk(b[2], b[3]); return w; }
DEV void unpack8(const u32x4 w, f32x4& a, f32x4& b) { a[0] = bflo(w[0]); a[1] = bfhi(w[0]); a[2] = bflo(w[1]); a[3] = bfhi(w[1]); b[0] = bflo(w[2]); b[1] = bfhi(w[2]); b[2] = bflo(w[3]); b[3] = bfhi(w[3]); }
DEV u32x4 quad_rows(const u32x4 w, int lane) { const int src = (lane >> 2) + 16 * (lane & 3); u32x4 r; r[0] = BPERM(src, w[0]); r[1] = BPERM(src, w[1]); r[2] = BPERM(src, w[2]); r[3] = BPERM(src, w[3]); return r; }
DEV float bperm_f(int src, float v) { return __builtin_bit_cast(float, BPERM(src, __builtin_bit_cast(unsigned, v))); }
DEV f32x4 quad_rows_f(const f32x4 w, int lane) { const int src = (lane >> 2) + 16 * (lane & 3); f32x4 r; r[0] = bperm_f(src, w[0]); r[1] = bperm_f(src, w[1]); r[2] = bperm_f(src, w[2]); r[3] = bperm_f(src, w[3]); return r; }
DEV float sigmoidf_(float v) { return RCPF(1.0f + EXP2F(-v * LOG2E)); }

constexpr size_t WOF_LR = 0, WOF_IN = 256 * 1024, WOF_BR = WOF_IN + (size_t)11 * 512 * 1024, WOF_O = WOF_BR + (size_t)2 * 512 * 1024, WOF_UP = WOF_O + (size_t)2 * 512 * 1024, WOF_DN = WOF_UP + (size_t)8 * 512 * 1024;
struct Ptrs {
    const float *x, *mix_g, *w_in, *relb, *wglr, *bgate, *gng, *wbr, *wout, *mlp_g, *wup, *wdn, *fin_g;
    float* res;
    bf16_t *proj, *wts, *XN, *DSS; float *OI, *DT; unsigned long long* SSQ;
    DEV bf16_t* QA() const { return proj + O_QA; } DEV bf16_t* VB() const { return proj + O_VB; } DEV bf16_t* KA() const { return proj + O_KA; } DEV bf16_t* VA() const { return proj + O_VA; }
    DEV bf16_t* QB() const { return proj + O_QB; } DEV bf16_t* KB() const { return proj + O_KB; } DEV bf16_t* RB() const { return proj + O_RB; } DEV bf16_t* LA() const { return proj + O_LA; }
    DEV bf16_t* GA() const { return proj + O_GA; } DEV bf16_t* GB() const { return proj + O_GB; } DEV bf16_t* T() const { return proj + O_KA; } DEV bf16_t* MERGED() const { return proj + O_QB; } DEV bf16_t* HID() const { return proj; }
    DEV bf16_t* Wlr_t() const { return wts + WOF_LR; } DEV bf16_t* Win_t() const { return wts + WOF_IN; } DEV bf16_t* Wbr_t() const { return wts + WOF_BR; } DEV bf16_t* Wo_t() const { return wts + WOF_O; }
    DEV bf16_t* Wup_t() const { return wts + WOF_UP; } DEV bf16_t* Wdn_t() const { return wts + WOF_DN; }
};

constexpr int ATT_KSTR = 528, ATT_VSTR = 576, ATT_KT = 64 * ATT_KSTR, ATT_VT = 64 * ATT_VSTR;
constexpr int ATT_K0 = 0, ATT_V0 = 2 * ATT_KT, ATT_BT = ATT_V0 + 2 * ATT_VT, ATT_END = ATT_BT + 4 * 260 * 4;
constexpr int G1_QSTR = 144, G1_ESTR = 192, G1_VSTR = 320;
constexpr int G1_QT = 0, G1_KT = G1_QT + 64 * G1_QSTR, G1_KE = G1_KT + 64 * G1_QSTR, G1_V = G1_KE + 64 * G1_ESTR, G1_TOT = G1_V + 64 * G1_VSTR, G1_END = G1_TOT + 8 * 64 * 4;
constexpr int CONV_SCR = 64 * 33 * 4;

DEV void phase_x0(const Ptrs& P, int gw, int ngw, int lane) {
    for (int row = gw; row < M; row += ngw) {
        const f32x4* xr = (const f32x4*)(P.x + (size_t)row * DM); u32x2* xn = (u32x2*)(P.XN + (size_t)row * DM);
        float s = 0.f;
#pragma unroll
        for (int j = 0; j < 4; ++j) { const f32x4 v = xr[lane + 64 * j]; s += (v[0] * v[0] + v[1] * v[1]) + (v[2] * v[2] + v[3] * v[3]);
            u32x2 o; o[0] = cvtpk(v[0], v[1]); o[1] = cvtpk(v[2], v[3]); xn[lane + 64 * j] = o; }
#pragma unroll
        for (int o = 1; o < 64; o <<= 1) s += SHFL_XOR(s, o);
        if (lane == 0) P.SSQ[row] = (unsigned long long)(s * SSQ_SCALE);
    }
}

DEV void phase_final(const Ptrs& P, int row_first, int row_end, int row_step, int lane) {
    const unsigned long long* ssq = P.SSQ + (size_t)8 * M;
    for (int row = row_first; row < row_end; row += row_step) {
        f32x4* rr = (f32x4*)(P.res + (size_t)row * DM); const f32x4* g = (const f32x4*)P.fin_g; const u32x2* xn = (const u32x2*)(P.XN + (size_t)row * DM);
        const float rs = ssq_rstd(ssq[row]);
#pragma unroll
        for (int j = 0; j < 4; ++j) { const u32x2 w = xn[lane + 64 * j]; f32x4 v = {bflo(w[0]), bfhi(w[0]), bflo(w[1]), bfhi(w[1])}; const f32x4 gg = g[lane + 64 * j]; v = v * rs * gg; rr[lane + 64 * j] = v; }
    }
}

struct ConvD { const float* W; bf16_t* WT; const float* gain; float scale; int ldw, K, ldt, k0, n0, gate; };
DEV ConvD conv_decode(const Ptrs& P, int lrest, int lin, int n_rest, int n_in, int it) {
    ConvD d; int r = it, nblk; d.gain = nullptr; d.scale = 1.f; d.gate = 0;
    if (r < n_rest) {
        if (r < 256) { d.W = P.wbr + (size_t)(2 * lrest) * 512 * DM; d.ldw = DM; d.K = 512; nblk = 32; d.WT = P.Wbr_t(); }
        else if (r < 512) { r -= 256; d.W = P.wbr + (size_t)(2 * lrest + 1) * 512 * DM; d.ldw = DM; d.K = 512; nblk = 32; d.WT = P.Wbr_t() + (size_t)DM * 512; }
        else if (r < 1024) { r -= 512; d.W = P.wout + (size_t)lrest * DM * DM; d.ldw = DM; d.K = DM; nblk = 32; d.WT = P.Wo_t(); }
        else if (r < 3072) { r -= 1024; d.W = P.wup + (size_t)lrest * DM * DFF; d.ldw = DFF; d.K = DM; nblk = 128; d.WT = P.Wup_t(); d.gain = P.mlp_g + lrest * DM; }
        else { r -= 3072; d.W = P.wdn + (size_t)lrest * DFF * DM; d.ldw = DM; d.K = DFF; nblk = 32; d.WT = P.Wdn_t(); }
    } else {
        r -= n_rest; const float* W0 = P.w_in + (size_t)lin * DM * INC; d.gain = P.mix_g + lin * DM; d.ldw = INC; d.K = DM; d.W = W0; d.WT = P.Win_t(); nblk = 1;
        if (r >= n_in) { d.gate = 1; r -= n_in; }
        else if (r < 256) { nblk = 16; d.scale = 0.125f * LOG2E; }
        else if (r < 768) { r -= 256; d.W = W0 + 512; nblk = 32; d.WT = P.Win_t() + (size_t)512 * DM; }
        else if (r < 896) { r -= 768; d.W = W0 + 1536; nblk = 8; d.WT = P.Win_t() + (size_t)1536 * DM; d.scale = 0.125f; }
        else if (r < 1536) { r -= 896; d.W = W0 + 1792; nblk = 40; d.WT = P.Win_t() + (size_t)1792 * DM; }
        else { r -= 1536; d.W = W0 + 3088; nblk = 64; d.WT = P.Win_t() + (size_t)3072 * DM; }
    }
    d.ldt = d.K == DFF ? LDH : d.K;
    if (d.gate) { d.k0 = r; d.n0 = 0; } else { d.k0 = 64 * (r / nblk); d.n0 = 32 * (r % nblk); }
    return d;
}
DEV void conv_load(const ConvD& d, f32x4 (&v)[8], int lane) {
    const float* src = d.W + (size_t)(d.k0 + (lane >> 3)) * d.ldw + d.n0 + 4 * (lane & 7);
#pragma unroll
    for (int i = 0; i < 8; ++i) v[i] = *(const f32x4*)(src + (size_t)(8 * i) * d.ldw);
}
DEV void conv_finish(const ConvD& d, const f32x4 (&v)[8], LAS float* scr, int lane) {
#pragma unroll
    for (int i = 0; i < 8; ++i) { const int kk = 8 * i + (lane >> 3); const float g = d.gain ? d.gain[d.k0 + kk] * d.scale : d.scale; LAS float* s = scr + kk * 33 + 4 * (lane & 7);
        s[0] = v[i][0] * g; s[1] = v[i][1] * g; s[2] = v[i][2] * g; s[3] = v[i][3] * g; }
    WAVE_LDS_SYNC();
    const int c = lane & 7;
#pragma unroll
    for (int j = 0; j < 4; ++j) { const int n = (lane >> 3) + 8 * j; const LAS float* s = scr + (8 * c) * 33 + n;
        u32x4 o; o[0] = cvtpk(s[0 * 33], s[1 * 33]); o[1] = cvtpk(s[2 * 33], s[3 * 33]); o[2] = cvtpk(s[4 * 33], s[5 * 33]); o[3] = cvtpk(s[6 * 33], s[7 * 33]);
        *(u32x4*)(d.WT + (size_t)(d.n0 + n) * d.ldt + d.k0 + 8 * c) = o; }
    WAVE_LDS_SYNC();
}
DEV void conv_lr_item(const float* w_in_l, const float* gain, bf16_t* Wlr_t, int it, int lane) {
#pragma unroll 1
    for (int j = 0; j < 4; ++j) { const int k = it * 256 + j * 64 + lane; const float g = gain[k]; const f32x4* src = (const f32x4*)(w_in_l + (size_t)k * INC + 3072);
#pragma unroll
        for (int q = 0; q < 4; ++q) { const f32x4 v = src[q];
#pragma unroll
            for (int e = 0; e < 4; ++e) Wlr_t[(size_t)(4 * q + e) * DM + k] = (bf16_t)(cvtpk(v[e] * g, 0.f) & 0xffffu); } }
}
DEV void conv_phase(const Ptrs& P, int lrest, int lin, LAS float* scr, int gw, int ngw, int lane) {
    const int n_rest = lrest >= 0 ? 5120 : 0, n_in = lin < DEPTH ? 2560 : 0, total = n_rest + n_in + (lin < DEPTH ? 4 : 0);
    int it = gw; if (it >= total) return;
    ConvD d = conv_decode(P, lrest, lin, n_rest, n_in, it); f32x4 v[8];
    if (!d.gate) conv_load(d, v, lane);
#pragma unroll 1
    for (;;) {
        const int itn = it + ngw; const bool more = itn < total; ConvD dn = d; f32x4 vn[8];
        if (more) { dn = conv_decode(P, lrest, lin, n_rest, n_in, itn); if (!dn.gate) conv_load(dn, vn, lane); }
        if (d.gate) conv_lr_item(d.W, d.gain, P.Wlr_t(), d.k0, lane); else conv_finish(d, v, scr, lane);
        if (!more) break;
        d = dn; it = itn;
#pragma unroll
        for (int i = 0; i < 8; ++i) v[i] = vn[i];
    }
}

constexpr int LR_PART = 0, LR_LRB = 8 * 64 * 16 * 4, LR_END = LR_LRB + 64 * 16 * 4;
DEV void lr_item(const Ptrs& P, int layer, lds_t lds, int bc) {
    int tid_ = threadIdx.x; OPAQUE_V(tid_); const int tid = tid_, lane = tid & 63, w = tid >> 6, l15 = lane & 15, lq = lane >> 4;
    const size_t row0 = (size_t)bc * 64;
    f32x4 acc[4];
#pragma unroll
    for (int m = 0; m < 4; ++m) acc[m] = (f32x4){0.f, 0.f, 0.f, 0.f};
#pragma unroll
    for (int ks = 0; ks < 4; ++ks) { const int k = 128 * w + 32 * ks + 8 * lq;
        const bf16x8 b = *(const bf16x8*)(P.Wlr_t() + (size_t)l15 * DM + k);
#pragma unroll
        for (int m = 0; m < 4; ++m) { const bf16x8 a = *(const bf16x8*)(P.XN + (row0 + 16 * m + l15) * DM + k); acc[m] = MFMA16(a, b, acc[m]); } }
    LAS float* part = (LAS float*)(lds + LR_PART); LAS float* lrb = (LAS float*)(lds + LR_LRB);
#pragma unroll
    for (int m = 0; m < 4; ++m)
#pragma unroll
        for (int r = 0; r < 4; ++r) part[(w * 64 + 16 * m + 4 * lq + r) * 16 + l15] = acc[m][r];
    __syncthreads();
    const unsigned long long* ssq = P.SSQ + (size_t)(2 * layer) * M;
#pragma unroll
    for (int i = 0; i < 2; ++i) { const int o = tid + NT * i, t = o >> 4; float s = 0.f;
#pragma unroll
        for (int ww = 0; ww < 8; ++ww) s += part[ww * 1024 + o];
        lrb[o] = s * ssq_rstd(ssq[row0 + t]); }
    __syncthreads();
    const int l31 = lane & 31, hi = lane >> 5, j = 32 * w + l31;
    bf16x8 bw;
    { float wv[8];
#pragma unroll
      for (int i = 0; i < 8; ++i) wv[i] = P.wglr[(size_t)(layer * 16 + 8 * hi + i) * 256 + j];
      u32x4 u; u[0] = cvtpk(wv[0], wv[1]); u[1] = cvtpk(wv[2], wv[3]); u[2] = cvtpk(wv[4], wv[5]); u[3] = cvtpk(wv[6], wv[7]); bw = __builtin_bit_cast(bf16x8, u); }
    const float bg = P.bgate[layer * 256 + j];
#pragma unroll
    for (int tb = 0; tb < 2; ++tb) {
        const f32x4 a0 = *(const LAS f32x4*)(lrb + (tb * 32 + l31) * 16 + 8 * hi), a1 = *(const LAS f32x4*)(lrb + (tb * 32 + l31) * 16 + 8 * hi + 4);
        const bf16x8 af = __builtin_bit_cast(bf16x8, pack8(a0, a1));
        f32x16 d;
#pragma unroll
        for (int r = 0; r < 16; ++r) d[r] = bg;
        d = MFMA32(af, bw, d);
#pragma unroll
        for (int r = 0; r < 16; ++r) { const float g = d[r];
            P.LA()[pofs(row0 + tb * 32 + crow(r, hi), 256) + j] = (bf16_t)(cvtpk((fminf(g, 0.f) - LOG2F(1.0f + EXP2F(-fabsf(g) * LOG2E)) * LN2) * 0.0625f, 0.f) & 0xffffu); } }
    __syncthreads();
}

template <bool STORE = true> DEV void att_unit(const Ptrs& P, int layer, lds_t lds, int b, int c, int hg) {
    int tid_ = threadIdx.x; OPAQUE_V(tid_); const int tid = tid_, lane = tid & 63, w = tid >> 6, hl = w >> 1, qb = w & 1, l31 = lane & 31, hi = lane >> 5;
    const int h = hg * 4 + hl; const size_t row0 = (size_t)b * SEQ;
    LAS float* bt = (LAS float*)(lds + ATT_BT);
    for (int i = tid; i < 4 * NREL; i += NT) { const int hh = i / NREL, j = i % NREL; bt[hh * 260 + j] = P.relb[(size_t)(layer * 8 + hg * 4 + hh) * NREL + j] * LOG2E; }
    const size_t qrow = row0 + c * 64 + qb * 32 + l31;
    bf16x8 qf[4];
#pragma unroll
    for (int ks = 0; ks < 4; ++ks) qf[ks] = *(const bf16x8*)(P.QA() + pofs(qrow, 512) + h * 64 + ks * 16 + hi * 8);
    f32x16 oT[2];
#pragma unroll
    for (int r = 0; r < 16; ++r) { oT[0][r] = 0.f; oT[1][r] = 0.f; }
    float mrun = -1e30f, lrun = 0.f;
    const int t0 = (c >= 8) ? 0 : 8 - c;
    u32x4 kreg[4], vreg[4];
    const unsigned gofs = (unsigned)((tid >> 5) * 512 + hg * 256 + (tid & 31) * 8), lkofs = (unsigned)((tid >> 5) * ATT_KSTR + (tid & 31) * 16), lvofs = (unsigned)((tid >> 5) * ATT_VSTR + (tid & 31) * 16);
#define ATT_LOAD(t) do { const bf16_t* kb_ = P.KA() + pofs(row0 + (size_t)(c - 8 + (t)) * 64, 512); const bf16_t* vb_ = kb_ + (O_VA - O_KA); _Pragma("unroll") for (int i = 0; i < 4; ++i) { \
        kreg[i] = *(const u32x4*)(kb_ + gofs + i * 16 * 512); vreg[i] = *(const u32x4*)(vb_ + gofs + i * 16 * 512); } } while (0)
#define ATT_STORE(buf) do { const lds_t kd_ = lds + ATT_K0 + (buf) * ATT_KT + lkofs, vd_ = lds + ATT_V0 + (buf) * ATT_VT + lvofs; _Pragma("unroll") for (int i = 0; i < 4; ++i) { \
        *(LAS u32x4*)(kd_ + i * 16 * ATT_KSTR) = kreg[i]; *(LAS u32x4*)(vd_ + i * 16 * ATT_VSTR) = vreg[i]; } } while (0)
    ATT_LOAD(t0); ATT_STORE(0);
    __syncthreads();
    for (int t = t0; t <= 8; ++t) {
        const int buf = (t - t0) & 1;
        if (t < 8) ATT_LOAD(t + 1);
        const lds_t Kb = lds + ATT_K0 + buf * ATT_KT + hl * 128, Vb = lds + ATT_V0 + buf * ATT_VT + hl * 128;
        f32x16 s[2];
#pragma unroll
        for (int kb2 = 0; kb2 < 2; ++kb2) { f32x16 acc;
#pragma unroll
            for (int r = 0; r < 16; ++r) acc[r] = 0.f;
#pragma unroll
            for (int ks = 0; ks < 4; ++ks) { const bf16x8 a = *(const LAS bf16x8*)(Kb + (kb2 * 32 + l31) * ATT_KSTR + (ks * 16 + hi * 8) * 2); acc = MFMA32(a, qf[ks], acc); }
            s[kb2] = acc; }
        const LAS float* bth = bt + hl * 260;
        float c0 = 0.f;
        if (t <= 5) c0 = bth[256];
        else { const int base = 512 + qb * 32 + l31 - t * 64;
#pragma unroll
            for (int kb2 = 0; kb2 < 2; ++kb2)
#pragma unroll
                for (int r = 0; r < 16; ++r) { int d = base - (kb2 * 32 + crow(r, hi)); d = d > 128 ? 128 : d; const float bv = bth[d + 128]; ADD_INPLACE(s[kb2][r], bv); } }
        float mx = s[0][0];
#pragma unroll
        for (int r = 0; r < 16; ++r) { mx = fmaxf(mx, s[0][r]); mx = fmaxf(mx, s[1][r]); }
        mx = fmaxf(mx, SHFL_XOR(mx, 32)) + c0;
        const bool up = mx > mrun + 8.0f;
        if (WAVE_ANY(up)) { const float mnew = up ? mx : mrun, alpha = EXP2F(mrun - mnew); mrun = mnew; lrun *= alpha;
#pragma unroll
            for (int r = 0; r < 16; ++r) { oT[0][r] *= alpha; oT[1][r] *= alpha; } }
        const f32x2 sh = {c0 - mrun, c0 - mrun}; f32x2 ps = {0.f, 0.f};
#pragma unroll
        for (int kb2 = 0; kb2 < 2; ++kb2)
#pragma unroll
            for (int r = 0; r < 16; r += 2) { const f32x2 v = (f32x2){s[kb2][r], s[kb2][r + 1]} + sh; const f32x2 e = {EXP2F(v[0]), EXP2F(v[1])}; s[kb2][r] = e[0]; s[kb2][r + 1] = e[1]; ps += e; }
        lrun += ps[0] + ps[1];
        bf16x8 pf[2][2];
#pragma unroll
        for (int kb2 = 0; kb2 < 2; ++kb2)
#pragma unroll
            for (int s2 = 0; s2 < 2; ++s2) { u32x4 u;
#pragma unroll
                for (int j = 0; j < 4; ++j) u[j] = cvtpk(s[kb2][8 * s2 + 2 * j], s[kb2][8 * s2 + 2 * j + 1]);
                pf[kb2][s2] = __builtin_bit_cast(bf16x8, u); }
#pragma unroll
        for (int db = 0; db < 2; ++db)
#pragma unroll
            for (int kb2 = 0; kb2 < 2; ++kb2)
#pragma unroll
                for (int s2 = 0; s2 < 2; ++s2) { const int keyb = kb2 * 32 + s2 * 16 + 4 * hi + ((lane & 15) >> 2), colb = db * 32 + 16 * ((lane >> 4) & 1) + 4 * (lane & 3);
                    const s16x4 lo = TR_READ(Vb + keyb * ATT_VSTR + colb * 2), h4 = TR_READ(Vb + (keyb + 8) * ATT_VSTR + colb * 2);
                    const bf16x8 a = {lo[0], lo[1], lo[2], lo[3], h4[0], h4[1], h4[2], h4[3]};
                    oT[db] = MFMA32(a, pf[kb2][s2], oT[db]); }
        if (t < 8) ATT_STORE(buf ^ 1);
        __syncthreads();
    }
#undef ATT_LOAD
#undef ATT_STORE
    const float inv = RCPF(lrun + SHFL_XOR(lrun, 32));
    bf16_t* yp = P.QA() + pofs(qrow, 512) + h * 64;
#pragma unroll
    for (int db = 0; db < 2; ++db)
#pragma unroll
        for (int g4 = 0; g4 < 4; ++g4) { u32x2 o; o[0] = cvtpk(oT[db][4 * g4] * inv, oT[db][4 * g4 + 1] * inv); o[1] = cvtpk(oT[db][4 * g4 + 2] * inv, oT[db][4 * g4 + 3] * inv);
            if (STORE) *(u32x2*)(yp + db * 32 + 8 * g4 + 4 * hi) = o; }
}

constexpr int NSC = NCH / 4, NUNIT = BATCH * 4 * NSC;
constexpr int GA_SET = 64 * G1_QSTR * 2 + 64 * G1_ESTR + 64 * G1_VSTR;
constexpr int GA_QT = 0, GA_KT = GA_QT + 64 * G1_QSTR, GA_KE = GA_KT + 64 * G1_QSTR, GA_V = GA_KE + 64 * G1_ESTR;
constexpr int GA_ST = 2 * GA_SET, GA_STSZ = 128 * G1_QSTR, GA_TOT = GA_ST + 2 * GA_STSZ, GA_DEC = GA_TOT + 2 * 8 * 64 * 4, GA_END = GA_DEC + 2 * 256;
template <bool STORE = true> DEV void gla_a_unit(const Ptrs& P, lds_t lds, int u) {
    int tid_ = threadIdx.x; OPAQUE_V(tid_); const int tid = tid_, lane = tid & 63, w = tid >> 6, l31 = lane & 31, hi = lane >> 5;
    const int sc = u % NSC, bh = u / NSC, h = bh & 3, b = bh >> 2;
    const int dvb = w >> 1, ib = w & 1;
    const int tt = lane & 7, db = lane >> 3, tk = 8 * w + tt;
    float dstart[8];
#pragma unroll
    for (int i = 0; i < 8; ++i) dstart[i] = 1.f;
    f32x16 st;
#pragma unroll
    for (int r = 0; r < 16; ++r) st[r] = 0.f;
    u32x4 la[4], qr[4], kr[4], vreg[4][2];
    bf16_t* const pan = P.proj + (size_t)(b * (SEQ / 256) + sc) * PBE;
    const unsigned eofs = (unsigned)(tk * 256 + h * 64 + 8 * db), vofs = (unsigned)((tid >> 4) * 512 + h * 128 + (tid & 15) * 8);
#pragma unroll
    for (int j = 0; j < 4; ++j) {
        la[j] = *(const u32x4*)(pan + O_LA + eofs + j * 64 * 256);
        qr[j] = *(const u32x4*)(pan + O_QB + eofs + j * 64 * 256); kr[j] = *(const u32x4*)(pan + O_KB + eofs + j * 64 * 256);
#pragma unroll
        for (int i = 0; i < 2; ++i) vreg[j][i] = *(const u32x4*)(pan + O_VB + vofs + (j * 64 + i * 32) * 512); }
    float mk[16];
#pragma unroll
    for (int r = 0; r < 16; ++r) mk[r] = crow(r, hi) > l31 ? 0.f : 1.f;
    const int colbV = dvb * 32 + 16 * ((lane >> 4) & 1) + 4 * (lane & 3), colbK = ib * 32 + 16 * ((lane >> 4) & 1) + 4 * (lane & 3);
    const float m1 = tt >= 1 ? 1.f : 0.f, m2 = tt >= 2 ? 1.f : 0.f, m4 = tt >= 4 ? 1.f : 0.f;
    const int grp = lane & ~7;
#pragma unroll
    for (int j = 0; j < 4; ++j) {
        const size_t row0 = ((size_t)b * NCH + 4 * sc + j) * 64; const size_t item = ((size_t)b * NCH + 4 * sc + j) * 4 + h;
        const lds_t S = lds + (j & 1) * GA_SET;
        LAS float* tot = (LAS float*)(lds + GA_TOT + (j & 1) * 2048); LAS float* dec = (LAS float*)(lds + GA_DEC + (j & 1) * 256);
        float lc[8];
        { f32x4 l0, l1; unpack8(la[j], l0, l1);
#pragma unroll
          for (int i = 0; i < 4; ++i) { lc[i] = l0[i]; lc[4 + i] = l1[i]; } }
#pragma unroll
        for (int i = 0; i < 8; ++i) lc[i] = fmaf(DPP_SHR_F(lc[i], 1), m1, lc[i]);
#pragma unroll
        for (int i = 0; i < 8; ++i) lc[i] = fmaf(DPP_SHR_F(lc[i], 2), m2, lc[i]);
#pragma unroll
        for (int i = 0; i < 8; ++i) lc[i] = fmaf(DPP_SHR_F(lc[i], 4), m4, lc[i]);
        if (tt == 7) { *(LAS f32x4*)(tot + w * 64 + 8 * db) = (f32x4){lc[0], lc[1], lc[2], lc[3]}; *(LAS f32x4*)(tot + w * 64 + 8 * db + 4) = (f32x4){lc[4], lc[5], lc[6], lc[7]}; }
#pragma unroll
        for (int i = 0; i < 2; ++i) { const int pc = tid + NT * i, row = pc >> 4, ch = pc & 15; *(LAS u32x4*)(S + GA_V + row * G1_VSTR + ch * 16) = vreg[j][i]; }
        __syncthreads();
        float off1 = 0.f, tot1 = 0.f;
#pragma unroll
        for (int s = 0; s < 8; ++s) { const float x = tot[s * 64 + 8 * db + tt]; tot1 += x; off1 += (s < w) ? x : 0.f; }
        const float dtot1 = EXP2F(tot1 * LOG2E);
        f32x4 q0, q1, k0, k1; unpack8(qr[j], q0, q1); unpack8(kr[j], k0, k1);
        float qt[8], kt[8], ke[8], qd[8];
#pragma unroll
        for (int i = 0; i < 8; ++i) { const float dti = bperm_f(grp + i, dtot1), bcur = bperm_f(grp + i, off1) + lc[i], qv = i < 4 ? q0[i & 3] : q1[i & 3], kv = i < 4 ? k0[i & 3] : k1[i & 3];
            qt[i] = qv * EXP2F(bcur * LOG2E); kt[i] = kv * EXP2F(-bcur * LOG2E); ke[i] = kt[i] * dti; qd[i] = qt[i] * dstart[i]; dstart[i] *= dti; }
        *(LAS u32x4*)(S + GA_QT + tk * G1_QSTR + db * 16) = pack8((f32x4){qt[0], qt[1], qt[2], qt[3]}, (f32x4){qt[4], qt[5], qt[6], qt[7]});
        *(LAS u32x4*)(S + GA_KT + tk * G1_QSTR + db * 16) = pack8((f32x4){kt[0], kt[1], kt[2], kt[3]}, (f32x4){kt[4], kt[5], kt[6], kt[7]});
        *(LAS u32x4*)(S + GA_KE + tk * G1_ESTR + db * 16) = pack8((f32x4){ke[0], ke[1], ke[2], ke[3]}, (f32x4){ke[4], ke[5], ke[6], ke[7]});
        if (STORE) *(u32x4*)(pan + O_QB + eofs + j * 64 * 256) = pack8((f32x4){qd[0], qd[1], qd[2], qd[3]}, (f32x4){qd[4], qd[5], qd[6], qd[7]});
        if (w == 0) dec[8 * db + tt] = dtot1;
        __syncthreads();
        f32x16 oi;
#pragma unroll
        for (int r = 0; r < 16; ++r) oi[r] = 0.f;
        for (int jb = 0; jb <= ib; ++jb) {
            f32x16 att;
#pragma unroll
            for (int r = 0; r < 16; ++r) att[r] = 0.f;
#pragma unroll
            for (int ks = 0; ks < 4; ++ks) { const bf16x8 a = *(const LAS bf16x8*)(S + GA_KT + (jb * 32 + l31) * G1_QSTR + (ks * 16 + hi * 8) * 2);
                const bf16x8 bq = *(const LAS bf16x8*)(S + GA_QT + (ib * 32 + l31) * G1_QSTR + (ks * 16 + hi * 8) * 2);
                att = MFMA32(a, bq, att); }
            if (jb == ib) {
#pragma unroll
                for (int r = 0; r < 16; ++r) att[r] *= mk[r]; }
#pragma unroll
            for (int s2 = 0; s2 < 2; ++s2) { u32x4 uu;
#pragma unroll
                for (int e = 0; e < 4; ++e) uu[e] = cvtpk(att[8 * s2 + 2 * e], att[8 * s2 + 2 * e + 1]);
                const bf16x8 pf = __builtin_bit_cast(bf16x8, uu);
                const int keyb = jb * 32 + s2 * 16 + 4 * hi + ((lane & 15) >> 2);
                const s16x4 lo = TR_READ(S + GA_V + keyb * G1_VSTR + colbV * 2), h4 = TR_READ(S + GA_V + (keyb + 8) * G1_VSTR + colbV * 2);
                const bf16x8 a = {lo[0], lo[1], lo[2], lo[3], h4[0], h4[1], h4[2], h4[3]};
                oi = MFMA32(a, pf, oi); }
        }
        if (j > 0) {
            const lds_t STp = lds + GA_ST + ((j - 1) & 1) * GA_STSZ;
#pragma unroll
            for (int ks = 0; ks < 4; ++ks) { const bf16x8 a = *(const LAS bf16x8*)(STp + (dvb * 32 + l31) * G1_QSTR + (ks * 16 + hi * 8) * 2);
                const bf16x8 bq = *(const LAS bf16x8*)(S + GA_QT + (ib * 32 + l31) * G1_QSTR + (ks * 16 + hi * 8) * 2);
                oi = MFMA32(a, bq, oi); } }
        { bf16_t* op = (bf16_t*)P.OI + (item * 8 + w) * 16 * 64 + lane * 8;
#pragma unroll
          for (int g8 = 0; g8 < 2; ++g8) *(u32x4*)(op + g8 * 512) = pack8((f32x4){oi[8 * g8], oi[8 * g8 + 1], oi[8 * g8 + 2], oi[8 * g8 + 3]}, (f32x4){oi[8 * g8 + 4], oi[8 * g8 + 5], oi[8 * g8 + 6], oi[8 * g8 + 7]}); }
        f32x16 ds;
#pragma unroll
        for (int r = 0; r < 16; ++r) ds[r] = 0.f;
#pragma unroll
        for (int s = 0; s < 4; ++s) { const int tb = s * 16 + 4 * hi + ((lane & 15) >> 2);
            const s16x4 alo = TR_READ(S + GA_V + tb * G1_VSTR + colbV * 2), ahi = TR_READ(S + GA_V + (tb + 8) * G1_VSTR + colbV * 2);
            const s16x4 blo = TR_READ(S + GA_KE + tb * G1_ESTR + colbK * 2), bhi = TR_READ(S + GA_KE + (tb + 8) * G1_ESTR + colbK * 2);
            const bf16x8 a = {alo[0], alo[1], alo[2], alo[3], ahi[0], ahi[1], ahi[2], ahi[3]}, bb = {blo[0], blo[1], blo[2], blo[3], bhi[0], bhi[1], bhi[2], bhi[3]};
            ds = MFMA32(a, bb, ds); }
        const float dl = dec[ib * 32 + l31];
#pragma unroll
        for (int r = 0; r < 16; ++r) st[r] = fmaf(dl, st[r], ds[r]);
        {
            const lds_t STn = lds + GA_ST + (j & 1) * GA_STSZ;
#pragma unroll
            for (int r = 0; r < 16; r += 2) { const unsigned pk = cvtpk(st[r], st[r + 1]);
                *(LAS bf16_t*)(STn + (dvb * 32 + crow(r, hi)) * G1_QSTR + (ib * 32 + l31) * 2) = (bf16_t)(pk & 0xffffu); *(LAS bf16_t*)(STn + (dvb * 32 + crow(r, hi) + 1) * G1_QSTR + (ib * 32 + l31) * 2) = (bf16_t)(pk >> 16); } }
    }
    __syncthreads();
    { const lds_t ST3 = lds + GA_ST + GA_STSZ;
#pragma unroll
      for (int i = 0; i < 2; ++i) { const int pc = tid + NT * i, row = pc >> 3, ch = pc & 7; *(u32x4*)(P.DSS + (size_t)u * 8192 + row * 64 + ch * 8) = *(const LAS u32x4*)(ST3 + row * G1_QSTR + ch * 16); } }
    if (tk == 0) { float* dtp = P.DT + (size_t)u * 64 + 8 * db; *(f32x4*)dtp = (f32x4){dstart[0], dstart[1], dstart[2], dstart[3]}; *(f32x4*)(dtp + 4) = (f32x4){dstart[4], dstart[5], dstart[6], dstart[7]}; }
    __syncthreads();
}

constexpr int GB_YSTR = 272;
constexpr int GB_ST = 0, GB_RED = 128 * G1_QSTR, GB_DT = GB_RED + 2048, GB_Q = GB_DT + 8 * 64 * 4, GB_QSZ = 64 * G1_QSTR, GB_TSZ = 64 * GB_YSTR, GB_RB = GB_Q + 2 * GB_QSZ, GB_Y = GB_RB + 2 * GB_TSZ, GB_END = GB_Y + 2 * GB_TSZ;
DEV void gla_b_unit(const Ptrs& P, int layer, lds_t lds, int u) {
    int tid_ = threadIdx.x; OPAQUE_V(tid_); const int tid = tid_, lane = tid & 63, w = tid >> 6, l31 = lane & 31, hi = lane >> 5;
    const int sc = u % NSC, bh = u / NSC, h = bh & 3, b = bh >> 2, u0 = u - sc;
    const int dvb = w >> 1, ib = w & 1;
    u32x4 on[2], qn, rbn[2];
    bf16_t* const pan = P.proj + (size_t)(b * (SEQ / 256) + sc) * PBE;
    const unsigned vofs = (unsigned)((tid >> 4) * 512 + h * 128 + (tid & 15) * 8), qofs = (unsigned)((tid >> 3) * 256 + h * 64 + (tid & 7) * 8);
#define GB_LOAD(j) do { const size_t item_ = ((size_t)b * NCH + 4 * sc + (j)) * 4 + h; const bf16_t* op = (const bf16_t*)P.OI + (item_ * 8 + w) * 16 * 64 + lane * 8; \
        _Pragma("unroll") for (int g8 = 0; g8 < 2; ++g8) on[g8] = *(const u32x4*)(op + g8 * 512); \
        _Pragma("unroll") for (int i = 0; i < 2; ++i) rbn[i] = *(const u32x4*)(pan + O_RB + vofs + ((j) * 64 + i * 32) * 512); \
        if (sc > 0) qn = *(const u32x4*)(pan + O_QB + qofs + (j) * 64 * 256); } while (0)
    GB_LOAD(0);
    f32x4 gg[4];
#pragma unroll
    for (int g4 = 0; g4 < 4; ++g4) gg[g4] = *(const f32x4*)(P.gng + layer * 512 + h * 128 + dvb * 32 + 8 * g4 + 4 * hi);
    if (sc > 0) {
        LAS float* dts = (LAS float*)(lds + GB_DT);
        bf16x8 vv[2][NSC - 1];
#pragma unroll
        for (int pp = 0; pp < 2; ++pp)
#pragma unroll
            for (int s = 0; s < NSC - 1; ++s) { const int ss = s < sc ? s : sc - 1; vv[pp][s] = *(const bf16x8*)(P.DSS + (size_t)(u0 + ss) * 8192 + (pp * NT + tid) * 8); }
        if (tid < (NSC - 1) * 64) { const int s = tid >> 6, ss = s < sc ? s : sc - 1; dts[tid] = P.DT[(size_t)(u0 + ss) * 64 + (tid & 63)]; }
        __syncthreads();
#pragma unroll
        for (int pp = 0; pp < 2; ++pp) { const int e8 = (pp * NT + tid) * 8, dkk = e8 & 63; f32x4 sa = {0.f, 0.f, 0.f, 0.f}, sb = {0.f, 0.f, 0.f, 0.f};
#pragma unroll
            for (int s = 0; s < NSC - 1; ++s) if (s < sc) { const f32x4 da = *(const LAS f32x4*)(dts + s * 64 + dkk), db = *(const LAS f32x4*)(dts + s * 64 + dkk + 4); f32x4 va, vb; unpack8(__builtin_bit_cast(u32x4, vv[pp][s]), va, vb);
                sa = da * sa + va; sb = db * sb + vb; }
            *(LAS u32x4*)(lds + GB_ST + (e8 >> 6) * G1_QSTR + dkk * 2) = pack8(sa, sb); }
    }
    LAS float* red = (LAS float*)(lds + GB_RED);
#define GB_YSTORE(jj) do { const lds_t ys_ = lds + GB_Y + ((jj) & 1) * GB_TSZ; _Pragma("unroll") for (int i = 0; i < 2; ++i) { const int pc = tid + NT * i; \
        *(u32x4*)(pan + O_VB + vofs + ((jj) * 64 + i * 32) * 512) = *(const LAS u32x4*)(ys_ + (pc >> 4) * GB_YSTR + (pc & 15) * 16); } } while (0)
#pragma unroll 1
    for (int j = 0; j < 4; ++j) {
        const lds_t Qt = lds + GB_Q + (j & 1) * GB_QSZ, Rt = lds + GB_RB + (j & 1) * GB_TSZ, Yt = lds + GB_Y + (j & 1) * GB_TSZ;
        f32x16 o;
#pragma unroll
        for (int g8 = 0; g8 < 2; ++g8) { f32x4 a, c; unpack8(on[g8], a, c);
#pragma unroll
            for (int e = 0; e < 4; ++e) { o[8 * g8 + e] = a[e]; o[8 * g8 + 4 + e] = c[e]; } }
#pragma unroll
        for (int i = 0; i < 2; ++i) { const int pc = tid + NT * i; *(LAS u32x4*)(Rt + (pc >> 4) * GB_YSTR + (pc & 15) * 16) = rbn[i]; }
        if (sc > 0) *(LAS u32x4*)(Qt + (tid >> 3) * G1_QSTR + (tid & 7) * 16) = qn;
        __syncthreads();
        if (j > 0) GB_YSTORE(j - 1);
        if (j < 3) GB_LOAD(j + 1);
        if (sc > 0) {
#pragma unroll
            for (int ks = 0; ks < 4; ++ks) { const bf16x8 a = *(const LAS bf16x8*)(lds + GB_ST + (dvb * 32 + l31) * G1_QSTR + (ks * 16 + hi * 8) * 2);
                const bf16x8 bq = *(const LAS bf16x8*)(Qt + (ib * 32 + l31) * G1_QSTR + (ks * 16 + hi * 8) * 2);
                o = MFMA32(a, bq, o); } }
        float ss = 0.f;
#pragma unroll
        for (int r = 0; r < 16; ++r) ss += o[r] * o[r];
        ss += SHFL_XOR(ss, 32);
        if (hi == 0) red[(j & 1) * 256 + w * 32 + l31] = ss;
        __syncthreads();
        const LAS float* rr = red + (j & 1) * 256;
        const float tot = (rr[ib * 32 + l31] + rr[(2 + ib) * 32 + l31]) + (rr[(4 + ib) * 32 + l31] + rr[(6 + ib) * 32 + l31]);
        const float rs = RSQF(tot * (1.0f / 128.f) + EPS);
#pragma unroll
        for (int g4 = 0; g4 < 4; ++g4) { const int dv0 = dvb * 32 + 8 * g4 + 4 * hi; const f32x4 g = gg[g4]; const int lo = (ib * 32 + l31) * GB_YSTR + dv0 * 2;
            const u32x2 rb = *(const LAS u32x2*)(Rt + lo);
            u32x2 ov; ov[0] = cvtpk(o[4 * g4] * rs * g[0] * bflo(rb[0]), o[4 * g4 + 1] * rs * g[1] * bfhi(rb[0])); ov[1] = cvtpk(o[4 * g4 + 2] * rs * g[2] * bflo(rb[1]), o[4 * g4 + 3] * rs * g[3] * bfhi(rb[1]));
            *(LAS u32x2*)(Yt + lo) = ov; }
    }
    __syncthreads();
    GB_YSTORE(3);
#undef GB_YSTORE
#undef GB_LOAD
    __syncthreads();
}
namespace pg8 {
#define PG8_LAS __attribute__((address_space(3)))
typedef unsigned short bf16_t;
typedef short bf16x8 __attribute__((ext_vector_type(8)));
typedef float f32x4 __attribute__((ext_vector_type(4)));
typedef unsigned u32x4 __attribute__((ext_vector_type(4)));
constexpr int BM = 256, BK = 64, HALF = 128, HTB = HALF * BK * 2  , STAGE_BYTES = 8 * HTB, NXCD = 8, WGM = 8;

__host__ __device__ __forceinline__ int lds_byte(int r, int c) { const int st = (r >> 4) * 2 + (c >> 5), rr = r & 15, cc = c & 31, ob = rr * 64 + cc * 2; return st * 1024 + (ob ^ (((ob >> 9) & 1) << 5)); }
__host__ __device__ __forceinline__ void stage_rc(int b, int& R, int& C) { const int st = b / 1024, sb = b % 1024, swz = sb ^ (((sb >> 9) & 1) << 5); R = (st >> 1) * 16 + swz / 64; C = (st & 1) * 32 + (swz % 64) / 2; }
__host__ __device__ __forceinline__ int perm32(int rho) { const int n = rho >> 4, i = rho & 15; return 8 * (i >> 2) + 4 * n + (i & 3); }

struct Unit { int pm, pn; };
struct Gemm { const bf16_t* A; const bf16_t* Bt; int M, N, K, lda, ldb; size_t a_tile_bytes; int amod; size_t ahi_bytes; };

struct StaticOrder {
    int nM, nN, nwg, G, c;
    __host__ __device__ void init(int M, int N, int G_, int c_) { nM = M / BM; nN = N / BM; nwg = nM * nN; G = G_; c = c_; }
    __host__ __device__ bool next(int i, Unit& u) const {
        const long L = (long)i * G + c; if (L >= nwg) return false;
        int wgid = (int)L; { const int q = nwg / NXCD, r = nwg % NXCD, xcd = wgid % NXCD, off = wgid / NXCD; wgid = (xcd < r ? xcd * (q + 1) : r * (q + 1) + (xcd - r) * q) + off; }
        const int nig = WGM * nN, gid = wgid / nig, fm = gid * WGM, gsz = (nM - fm) < WGM ? (nM - fm) : WGM;
        u.pm = fm + ((wgid % nig) % gsz); u.pn = (wgid % nig) / gsz; return true;
    }
    __device__ __forceinline__ void a_ready(const Unit&) const {}
    __device__ __forceinline__ void done(const Unit&) const {}
};

template <class Epi, class Sched, bool ALIGN_EPI = false, bool SP2 = false>
__device__ __forceinline__ void gemm_phase(PG8_LAS unsigned char* lds, const Gemm g, const Sched& S, const Epi& E) {
    int tid_ = threadIdx.x; asm volatile("" : "+v"(tid_));
    const int tid = tid_, wid = __builtin_amdgcn_readfirstlane(tid >> 6), lane = tid & 63, wr = wid >> 2, wc = wid & 3, fr = lane & 15, fq = lane >> 4;
    const int K = g.K, nt = K / BK;
    unsigned voffA[2], voffB[2];
#pragma unroll
    for (int i = 0; i < 2; ++i) { int R, C; stage_rc(tid * 16 + i * 8192, R, C); const int Rb = Epi::PERM ? ((R & ~31) + perm32(R & 31)) : R;
        voffA[i] = (unsigned)(R * g.lda + C) * 2u; voffB[i] = (unsigned)(Rb * g.ldb + C) * 2u; }
    const size_t kstep = (size_t)(BK * 2);
    const size_t hstepA = (size_t)HALF * g.lda * 2, hstepB = (size_t)HALF * g.ldb * 2;
    const size_t tstepB = 2 * hstepB;
#define PG8_AOF(pm_) ((const char*)g.A + (size_t)((pm_) % g.amod) * g.a_tile_bytes + (size_t)((pm_) / g.amod) * g.ahi_bytes)
    const unsigned ldsw = (unsigned)wid * 1024u;
    const int aoff = lds_byte(wr * 64 + fr, fq * 8), boff = lds_byte(wc * 32 + fr, fq * 8);
#define PG8_SA(b, h) (((b) * 2 + (h)) * HTB)
#define PG8_SB(b, h) ((4 + (b) * 2 + (h)) * HTB)
#define PG8_STAGE(bufoff, gbase, voff) do { _Pragma("unroll") for (int _i = 0; _i < 2; ++_i) \
        __builtin_amdgcn_global_load_lds((const unsigned*)((const char*)(gbase) + (voff)[_i]), (PG8_LAS unsigned*)(lds + (bufoff) + ldsw + _i * 8192), 16, 0, 0); } while (0)
#define PG8_LDA(dst, b, h) do { _Pragma("unroll") for (int m = 0; m < 4; ++m) _Pragma("unroll") for (int k = 0; k < 2; ++k) dst[m][k] = *(const PG8_LAS bf16x8*)(lds + PG8_SA(b, h) + aoff + m * 2048 + k * 1024); } while (0)
#define PG8_LDB(dst, b, h) do { _Pragma("unroll") for (int n = 0; n < 2; ++n) _Pragma("unroll") for (int k = 0; k < 2; ++k) dst[n][k] = *(const PG8_LAS bf16x8*)(lds + PG8_SB(b, h) + boff + n * 2048 + k * 1024); } while (0)
#define PG8_MMA(ai, bj, At, Bt) do { __builtin_amdgcn_s_setprio(1); _Pragma("unroll") for (int m = 0; m < 4; ++m) _Pragma("unroll") for (int n = 0; n < 2; ++n) _Pragma("unroll") for (int k = 0; k < 2; ++k) \
        acc[ai][bj][m][n] = __builtin_amdgcn_mfma_f32_16x16x32_bf16(Bt[n][k], At[m][k], acc[ai][bj][m][n], 0, 0, 0); __builtin_amdgcn_s_setprio(0); } while (0)
#define PG8_WAIT_V(n) asm volatile("s_waitcnt vmcnt(" #n ")" ::: "memory")
#define PG8_WAIT_L(n) asm volatile("s_waitcnt lgkmcnt(" #n ")" ::: "memory")
#define PG8_BAR __builtin_amdgcn_s_barrier()
#define PG8_SCHED __builtin_amdgcn_sched_barrier(0)
    Unit cur, nxt; int ui = 0;
    if (!S.next(0, cur)) return;
    f32x4 acc[2][2][4][2];
#pragma unroll
    for (int a = 0; a < 2; ++a)
#pragma unroll
        for (int b = 0; b < 2; ++b)
#pragma unroll
            for (int m = 0; m < 4; ++m)
#pragma unroll
                for (int n = 0; n < 2; ++n) acc[a][b][m][n] = (f32x4){0.f, 0.f, 0.f, 0.f};
    bf16x8 At[4][2], B0[2][2], B1[2][2];
    const char* cA = PG8_AOF(cur.pm); const char* cB = (const char*)g.Bt + (size_t)cur.pn * tstepB;
    S.a_ready(cur);
    if constexpr (SP2) {
        PG8_STAGE(PG8_SB(0, 0), cB, voffB); PG8_STAGE(PG8_SB(0, 1), cB + hstepB, voffB); PG8_STAGE(PG8_SA(0, 0), cA, voffA); PG8_STAGE(PG8_SA(0, 1), cA + hstepA, voffA);
        if (wr == 1) PG8_BAR;
        PG8_WAIT_V(2); PG8_BAR;
        PG8_STAGE(PG8_SB(1, 0), cB + kstep, voffB); PG8_STAGE(PG8_SA(1, 0), cA + kstep, voffA); PG8_STAGE(PG8_SB(1, 1), cB + hstepB + kstep, voffB);
        PG8_WAIT_V(6); PG8_BAR;
    } else {
        PG8_STAGE(PG8_SB(0, 0), cB, voffB); PG8_STAGE(PG8_SA(0, 0), cA, voffA); PG8_STAGE(PG8_SB(0, 1), cB + hstepB, voffB); PG8_STAGE(PG8_SA(0, 1), cA + hstepA, voffA);
        if (wr == 1) PG8_BAR;
        PG8_WAIT_V(4); PG8_BAR;
        PG8_STAGE(PG8_SB(1, 0), cB + kstep, voffB); PG8_STAGE(PG8_SA(1, 0), cA + kstep, voffA); PG8_STAGE(PG8_SB(1, 1), cB + hstepB + kstep, voffB);
        PG8_WAIT_V(6); PG8_BAR;
    }
    for (;;) {
        const bool has_next = S.next(ui + 1, nxt);
        const char* nA = has_next ? PG8_AOF(nxt.pm) : cA; const char* nB = has_next ? (const char*)g.Bt + (size_t)nxt.pn * tstepB : cB;
        for (int t = 0; t < nt; t += 2) {
            const bool last = (t == nt - 2);
            const char* a1 = cA + (size_t)(t + 1) * kstep;
            const char* a2 = last ? nA : cA + (size_t)(t + 2) * kstep; const char* b2 = last ? nB : cB + (size_t)(t + 2) * kstep;
            const char* a3 = a2 + kstep; const char* b3 = b2 + kstep;
            if (last && has_next) S.a_ready(nxt);
            if constexpr (SP2) {
            PG8_LDB(B0, 0, 0); PG8_LDB(B1, 0, 1); PG8_SCHED; PG8_LDA(At, 0, 0); PG8_STAGE(PG8_SA(1, 1), a1 + hstepA, voffA);
            PG8_WAIT_V(8); PG8_WAIT_L(0); PG8_BAR; PG8_MMA(0, 0, At, B0); PG8_MMA(0, 1, At, B1); PG8_BAR; PG8_SCHED;
            PG8_LDA(At, 0, 1); PG8_STAGE(PG8_SB(0, 0), b2, voffB); PG8_STAGE(PG8_SB(0, 1), b2 + hstepB, voffB); PG8_STAGE(PG8_SA(0, 0), a2, voffA);
            PG8_WAIT_V(8); PG8_WAIT_L(0); PG8_BAR; PG8_MMA(1, 0, At, B0); PG8_MMA(1, 1, At, B1); PG8_BAR; PG8_SCHED;
            PG8_LDB(B0, 1, 0); PG8_LDB(B1, 1, 1); PG8_SCHED; PG8_LDA(At, 1, 0); PG8_STAGE(PG8_SA(0, 1), a2 + hstepA, voffA);
            PG8_WAIT_V(8); PG8_WAIT_L(0); PG8_BAR; PG8_MMA(0, 0, At, B0); PG8_MMA(0, 1, At, B1); PG8_BAR; PG8_SCHED;
            PG8_LDA(At, 1, 1); PG8_STAGE(PG8_SB(1, 0), b3, voffB); PG8_STAGE(PG8_SB(1, 1), b3 + hstepB, voffB); PG8_STAGE(PG8_SA(1, 0), a3, voffA);
            PG8_WAIT_V(8); PG8_WAIT_L(0); PG8_BAR; PG8_MMA(1, 0, At, B0); PG8_MMA(1, 1, At, B1); PG8_BAR; PG8_SCHED;
            } else {
            PG8_LDB(B0, 0, 0); PG8_SCHED; PG8_LDA(At, 0, 0); PG8_STAGE(PG8_SA(1, 1), a1 + hstepA, voffA);
            PG8_WAIT_L(8); PG8_BAR; PG8_WAIT_L(0); PG8_MMA(0, 0, At, B0); PG8_BAR; PG8_SCHED;
            PG8_LDB(B1, 0, 1); PG8_STAGE(PG8_SB(0, 0), b2, voffB);
            PG8_BAR; PG8_WAIT_L(0); PG8_MMA(0, 1, At, B1); PG8_BAR;
            PG8_LDA(At, 0, 1); PG8_STAGE(PG8_SA(0, 0), a2, voffA);
            PG8_BAR; PG8_WAIT_L(0); PG8_MMA(1, 0, At, B0); PG8_BAR; PG8_SCHED;
            PG8_STAGE(PG8_SB(0, 1), b2 + hstepB, voffB);
            PG8_WAIT_V(6); PG8_BAR; PG8_MMA(1, 1, At, B1); PG8_BAR;
            PG8_LDB(B0, 1, 0); PG8_SCHED; PG8_LDA(At, 1, 0); PG8_STAGE(PG8_SA(0, 1), a2 + hstepA, voffA);
            PG8_WAIT_L(8); PG8_BAR; PG8_WAIT_L(0); PG8_MMA(0, 0, At, B0); PG8_BAR; PG8_SCHED;
            PG8_LDB(B1, 1, 1); PG8_STAGE(PG8_SB(1, 0), b3, voffB);
            PG8_BAR; PG8_WAIT_L(0); PG8_MMA(0, 1, At, B1); PG8_BAR;
            PG8_LDA(At, 1, 1); PG8_STAGE(PG8_SA(1, 0), a3, voffA);
            PG8_BAR; PG8_WAIT_L(0); PG8_MMA(1, 0, At, B0); PG8_BAR; PG8_SCHED;
            PG8_STAGE(PG8_SB(1, 1), b3 + hstepB, voffB);
            PG8_WAIT_V(6); PG8_BAR; PG8_MMA(1, 1, At, B1); PG8_BAR;
            }
        }
        if constexpr (ALIGN_EPI) { if (wr == 0) PG8_BAR; }
        if constexpr (!Epi::AFTER_DRAIN) { E(acc, cur, wr, wc, fr, fq); S.done(cur); }
        if (!has_next) break;
#pragma unroll
        for (int a = 0; a < 2; ++a)
#pragma unroll
            for (int b = 0; b < 2; ++b)
#pragma unroll
                for (int m = 0; m < 4; ++m)
#pragma unroll
                    for (int n = 0; n < 2; ++n) acc[a][b][m][n] = (f32x4){0.f, 0.f, 0.f, 0.f};
        cur = nxt; cA = nA; cB = nB; ++ui;
        if constexpr (ALIGN_EPI) { if (wr == 1) PG8_BAR; }
    }
    PG8_WAIT_V(0);
    if constexpr (!ALIGN_EPI) { if (wr == 0) PG8_BAR; }
    PG8_BAR;
    if constexpr (Epi::AFTER_DRAIN) { E.fused(acc, cur, wr, wc, fr, fq, lds, wid, lane); S.done(cur); }
#undef PG8_AOF
#undef PG8_SA
#undef PG8_SB
#undef PG8_STAGE
#undef PG8_LDA
#undef PG8_LDB
#undef PG8_MMA
#undef PG8_WAIT_V
#undef PG8_WAIT_L
#undef PG8_BAR
#undef PG8_SCHED
}
}
#ifdef EMU
namespace pg8 { struct Unit { int pm, pn; }; constexpr int BM = 256, HALF = 128; }
#endif
typedef f32x4 acc_t[2][2][4][2];

struct EpiIn {
    static constexpr bool PERM = true, AFTER_DRAIN = false;
    Ptrs P; const unsigned long long* ssq; const LAS float* rs_lds; int pm_lds;
    DEV void operator()(const acc_t& acc, const pg8::Unit& u, int wr, int wc, int fr_, int fq_) const {
        int fr = fr_, fq = fq_; OPAQUE_V(fr); OPAQUE_V(fq);
        const int pn = u.pn; bf16_t* base; int ld, c0, act = 0;
        if (pn < 2) { base = P.QA(); ld = 512; c0 = pn * 256; } else if (pn < 4) { base = P.KA(); ld = 512; c0 = (pn - 2) * 256; } else if (pn < 6) { base = P.VA(); ld = 512; c0 = (pn - 4) * 256; }
        else if (pn == 6) { base = P.QB(); ld = 256; c0 = 0; } else if (pn == 7) { base = P.KB(); ld = 256; c0 = 0; } else if (pn < 10) { base = P.VB(); ld = 512; c0 = (pn - 8) * 256; }
        else if (pn < 12) { base = P.RB(); ld = 512; c0 = (pn - 10) * 256; act = 1; }
        else if (pn < 16) { base = P.GA(); ld = 1024; c0 = (pn - 12) * 256; act = 2; } else { base = P.GB(); ld = 1024; c0 = (pn - 16) * 256; act = 2; }
        base += (size_t)u.pm * PBE;
        const int rowb = wr * 64 + fr, colb = c0 + wc * 32 + 8 * fq;
        float rs[2][4];
        const float bad = (u.pm == pm_lds) ? 1.0f : __builtin_nanf("");
#pragma unroll
        for (int ai = 0; ai < 2; ++ai)
#pragma unroll
            for (int m = 0; m < 4; ++m) rs[ai][m] = rs_lds[wr * 64 + fr + ai * 128 + m * 16] * bad;
        if (act == 0) body<0>(acc, rs, base, ld, rowb, colb); else if (act == 1) body<1>(acc, rs, base, ld, rowb, colb); else body<2>(acc, rs, base, ld, rowb, colb);
    }
    template <int ACT> DEV static void body(const acc_t& acc, const float (&rs)[2][4], bf16_t* base, int ld, int rowb, int colb) {
        const int lane = (rowb & 15) + 16 * (((colb & 31)) >> 3), r2 = (rowb & ~15) + (lane >> 2), c2 = (colb & ~31) + 8 * (lane & 3);
#pragma unroll
        for (int ai = 0; ai < 2; ++ai)
#pragma unroll
            for (int m = 0; m < 4; ++m) { bf16_t* rowp = base + (size_t)(r2 + ai * 128 + m * 16) * ld + c2;
#pragma unroll
                for (int bj = 0; bj < 2; ++bj) { const float sc_ = (ACT == 2) ? rs[ai][m] * -LOG2E : rs[ai][m];
                    f32x4 v0 = acc[ai][bj][m][0] * sc_, v1 = acc[ai][bj][m][1] * sc_;
                    if (ACT == 1) {
#pragma unroll
                        for (int e = 0; e < 4; ++e) { v0[e] = v0[e] * sigmoidf_(v0[e]); v1[e] = v1[e] * sigmoidf_(v1[e]); } }
                    else if (ACT == 2) {
#pragma unroll
                        for (int e = 0; e < 4; ++e) { v0[e] = RCPF(1.0f + EXP2F(v0[e])); v1[e] = RCPF(1.0f + EXP2F(v1[e])); } }
                    ST16_WT(rowp + bj * 128, quad_rows(pack8(v0, v1), lane)); }
                SCHED_FENCE(); }
    }
};
struct EpiMerge {
    static constexpr bool PERM = true, AFTER_DRAIN = false;
    Ptrs P;
    DEV void operator()(const acc_t& acc, const pg8::Unit& u, int wr, int wc, int fr_, int fq_) const {
        int fr = fr_, fq = fq_; OPAQUE_V(fr); OPAQUE_V(fq);
        const int br = u.pm >= (M / 256) ? 1 : 0, pm = u.pm - br * (M / 256), pn = u.pn - br * 4;
        const bf16_t* gate = br ? P.GB() : P.GA();
        const int lane = fr + 16 * fq, rowb = wr * 64 + (lane >> 2), colb = pn * 256 + wc * 32 + 8 * (lane & 3);
        const size_t pb = (size_t)pm * PBE;
        if (br == 0) body<0>(acc, gate, P.T(), P.MERGED(), pb, rowb, colb, lane); else body<1>(acc, gate, P.T(), P.MERGED(), pb, rowb, colb, lane);
    }
    template <int BR> DEV static void body(const acc_t& acc, const bf16_t* gate, bf16_t* T, bf16_t* MG, size_t pb, int rowb, int colb, int lane) {
#pragma unroll
        for (int ai = 0; ai < 2; ++ai) {
            u32x4 gv[4][2], tv[4][2];
#pragma unroll
            for (int m = 0; m < 4; ++m) { const size_t off = pb + (size_t)(rowb + ai * 128 + m * 16) * 1024 + colb;
#pragma unroll
                for (int bj = 0; bj < 2; ++bj) { gv[m][bj] = *(const u32x4*)(gate + off + bj * 128); if (BR) tv[m][bj] = *(const u32x4*)(T + off + bj * 128); } }
#pragma unroll
            for (int m = 0; m < 4; ++m) { const size_t off = pb + (size_t)(rowb + ai * 128 + m * 16) * 1024 + colb;
#pragma unroll
                for (int bj = 0; bj < 2; ++bj) { f32x4 g0, g1; unpack8(gv[m][bj], g0, g1);
                    f32x4 v0 = quad_rows_f(acc[ai][bj][m][0], lane) * g0, v1 = quad_rows_f(acc[ai][bj][m][1], lane) * g1;
                    if (BR == 0) *(u32x4*)(T + off + bj * 128) = pack8(v0, v1);
                    else { f32x4 t0, t1; unpack8(tv[m][bj], t0, t1); ST16_WT(MG + off + bj * 128, pack8(v0 + t0, v1 + t1)); } } }
            SCHED_FENCE();
        }
    }
};
template <bool DRY = false> struct EpiResT {
    static constexpr bool PERM = true, AFTER_DRAIN = false;
    Ptrs P; unsigned long long* ssq_out;
    DEV void operator()(const acc_t& acc, const pg8::Unit& u, int wr, int wc, int fr_, int fq_) const {
        int fr = fr_, fq = fq_; OPAQUE_V(fr); OPAQUE_V(fq);
        const int lane = fr + 16 * fq, rowb = u.pm * 256 + wr * 64 + (lane >> 2), colb = u.pn * 256 + wc * 32 + 8 * (lane & 3);
#pragma unroll
        for (int ai = 0; ai < 2; ++ai) {
            u32x4 xv[4][2];
#pragma unroll
            for (int m = 0; m < 4; ++m)
#pragma unroll
                for (int bj = 0; bj < 2; ++bj) xv[m][bj] = *(const u32x4*)(P.XN + (size_t)(rowb + ai * 128 + m * 16) * DM + colb + bj * 128);
#pragma unroll
            for (int m = 0; m < 4; ++m) { const int row = rowb + ai * 128 + m * 16; const size_t off = (size_t)row * DM + colb; float s = 0.f;
#pragma unroll
                for (int bj = 0; bj < 2; ++bj) { bf16_t* xp = P.XN + off + bj * 128; f32x4 r0, r1; unpack8(xv[m][bj], r0, r1);
                    r0 += quad_rows_f(acc[ai][bj][m][0], lane); r1 += quad_rows_f(acc[ai][bj][m][1], lane); if (!DRY) ST16_WT(xp, pack8(r0, r1)); else if (r0[0] == 1.2345e30f) ST16_WT(xp, pack8(r0, r1));
                    s += ((r0[0] * r0[0] + r0[1] * r0[1]) + (r0[2] * r0[2] + r0[3] * r0[3])) + ((r1[0] * r1[0] + r1[1] * r1[1]) + (r1[2] * r1[2] + r1[3] * r1[3])); }
                s += SHFL_XOR(s, 1); s += SHFL_XOR(s, 2);
                if ((lane & 3) == 0 && (!DRY || s == 1.2345e30f)) ATOMIC_ADD_U64(ssq_out + row, (unsigned long long)(s * SSQ_SCALE)); }
        }
    }
};
typedef EpiResT<false> EpiRes;
struct EpiUp {
    static constexpr bool PERM = true, AFTER_DRAIN = false;
    Ptrs P; const unsigned long long* ssq; const LAS float* rs_lds; int pm_lds;
    DEV void operator()(const acc_t& acc, const pg8::Unit& u, int wr, int wc, int fr_, int fq_) const {
        int fr = fr_, fq = fq_; OPAQUE_V(fr); OPAQUE_V(fq);
        const int rowb = u.pm * 256 + wr * 64 + fr, colb = u.pn * 256 + wc * 32 + 8 * fq;
        float rs[2][4];
        const float bad = (u.pm == pm_lds) ? 1.0f : __builtin_nanf("");
#pragma unroll
        for (int ai = 0; ai < 2; ++ai)
#pragma unroll
            for (int m = 0; m < 4; ++m) rs[ai][m] = rs_lds[wr * 64 + fr + ai * 128 + m * 16] * bad;
        const int lane = fr + 16 * fq, r2 = wr * 64 + (lane >> 2), c2 = u.pn * 256 + wc * 32 + 8 * (lane & 3);
#pragma unroll
        for (int ai = 0; ai < 2; ++ai)
#pragma unroll
            for (int m = 0; m < 4; ++m) { bf16_t* rowp = P.HID() + (size_t)u.pm * PBE + (size_t)(r2 + ai * 128 + m * 16) * LDH + c2;
#pragma unroll
                for (int bj = 0; bj < 2; ++bj) { f32x4 v0 = acc[ai][bj][m][0] * rs[ai][m], v1 = acc[ai][bj][m][1] * rs[ai][m];
#pragma unroll
                    for (int e = 0; e < 4; ++e) { v0[e] = fmaxf(v0[e], 0.f); v0[e] *= v0[e]; v1[e] = fmaxf(v1[e], 0.f); v1[e] *= v1[e]; }
                    ST16_WT(rowp + bj * 128, quad_rows(pack8(v0, v1), lane)); } }
    }
};
#define XB_TMO      128
#define XB_XCNT(j)  (256  + 64 * (j))
#define XB_XSUB(j)  (1280 + 64 * (j))
#define XB_XGEN(j)  (2304 + 64 * (j))
#define XB_TOP      3328
#define XB_TOPGEN   3392
#define XCD_BAR_WORDS 3456
#define XB_SPIN_CAP (1u << 18)

__device__ __forceinline__ unsigned xb_ld(unsigned* p)              { return __hip_atomic_load(p, __ATOMIC_RELAXED, __HIP_MEMORY_SCOPE_AGENT); }
__device__ __forceinline__ unsigned xb_add(unsigned* p, unsigned v) { return __hip_atomic_fetch_add(p, v, __ATOMIC_RELAXED, __HIP_MEMORY_SCOPE_AGENT); }
__device__ __forceinline__ unsigned xb_xcc_id() { return (unsigned)__builtin_amdgcn_s_getreg((3 << 11) | 20) & 0xFu; }
#define XB_SPIN(cond, bar) do { unsigned _sp = 0; while (cond) { __builtin_amdgcn_s_sleep(1); \
    if ((++_sp & 255u) == 0u) { if (xb_ld(&(bar)[XB_TMO])) break; if (_sp > XB_SPIN_CAP) { atomicAdd(&(bar)[XB_TMO], 1u); break; } } } } while (0)

struct XcdBarrier {
    unsigned* bar; unsigned x;
    volatile LAS unsigned* st;
};

__device__ __forceinline__ XcdBarrier xcd_barrier_post(unsigned* bar, volatile LAS unsigned* st) {
    XcdBarrier b; b.bar = bar; b.x = xb_xcc_id(); b.st = st;
    if (threadIdx.x == 0) (void)xb_add(&bar[XB_XCNT(b.x)], 1u);
    return b;
}
__device__ __forceinline__ void xcd_barrier_complete(unsigned* bar, unsigned x, unsigned& nloc, unsigned& nx) {
    const unsigned G = gridDim.x * gridDim.y * gridDim.z;
    unsigned sum, cnt, mine, sp = 0u;
    for (;;) {
        sum = 0u; cnt = 0u; mine = 0u;
#pragma unroll
        for (unsigned j = 0; j < 16; ++j) { const unsigned c = xb_ld(&bar[XB_XCNT(j)]); sum += c; cnt += (c > 0u) ? 1u : 0u; mine = (j == x) ? c : mine; }
        if (sum == G) break;
        __builtin_amdgcn_s_sleep(1);
        if ((++sp & 255u) == 0u) { if (xb_ld(&bar[XB_TMO])) break; if (sp > XB_SPIN_CAP) { atomicAdd(&bar[XB_TMO], 1u); break; } }
    }
    nloc = mine > 0u ? mine : 1u; nx = cnt > 0u ? cnt : 1u;
}

__device__ __forceinline__ void xcd_barrier(const XcdBarrier& b) {
    asm volatile("s_waitcnt vmcnt(0)" ::: "memory");
    __syncthreads();
    if (threadIdx.x == 0) {
        unsigned* bar = b.bar;
        __builtin_amdgcn_s_waitcnt(0);
        unsigned nloc = b.st[0], nx = b.st[1];
        if (nloc == 0u) { xcd_barrier_complete(bar, b.x, nloc, nx); b.st[0] = nloc; b.st[1] = nx; }
        const unsigned old = xb_add(&bar[XB_XSUB(b.x)], 1u);
        const unsigned gen = old / nloc;
        if (old + 1u == (gen + 1u) * nloc) {
            __builtin_amdgcn_fence(__ATOMIC_RELEASE, "agent");
            asm volatile("s_waitcnt vmcnt(0)" ::: "memory");
            const unsigned og = xb_add(&bar[XB_TOP], 1u);
            const unsigned tg = og / nx;
            if (og + 1u == (tg + 1u) * nx) xb_add(&bar[XB_TOPGEN], 1u);
            else XB_SPIN(xb_ld(&bar[XB_TOPGEN]) == tg, bar);
            __builtin_amdgcn_fence(__ATOMIC_ACQUIRE, "agent");
            xb_add(&bar[XB_XGEN(b.x)], 1u);
            asm volatile("s_waitcnt vmcnt(0)" ::: "memory");
        } else {
            XB_SPIN(xb_ld(&bar[XB_XGEN(b.x)]) == gen, bar);
            __builtin_amdgcn_fence(__ATOMIC_ACQUIRE, "agent");
            asm volatile("s_waitcnt vmcnt(0)" ::: "memory");
        }
    }
    __syncthreads();
}

__device__ __forceinline__ void xcd_barrier_arrive(const XcdBarrier& b) {
    asm volatile("s_waitcnt vmcnt(0)" ::: "memory");
    __syncthreads();
    if (threadIdx.x == 0) {
        unsigned* bar = b.bar;
        __builtin_amdgcn_s_waitcnt(0);
        unsigned nloc = b.st[0], nx = b.st[1];
        if (nloc == 0u) { xcd_barrier_complete(bar, b.x, nloc, nx); b.st[0] = nloc; b.st[1] = nx; }
        const unsigned old = xb_add(&bar[XB_XSUB(b.x)], 1u);
        const unsigned gen = old / nloc;
        if (old + 1u == (gen + 1u) * nloc) {
            __builtin_amdgcn_fence(__ATOMIC_RELEASE, "agent");
            asm volatile("s_waitcnt vmcnt(0)" ::: "memory");
            const unsigned og = xb_add(&bar[XB_TOP], 1u);
            const unsigned tg = og / nx;
            if (og + 1u == (tg + 1u) * nx) xb_add(&bar[XB_TOPGEN], 1u);
            b.st[2] = 1u; b.st[3] = tg;
        } else { b.st[2] = 0u; b.st[3] = gen; }
    }
}
__device__ __forceinline__ void xcd_barrier_wait(const XcdBarrier& b) {
    if (threadIdx.x == 0) {
        unsigned* bar = b.bar; const unsigned g = b.st[3];
        if (b.st[2]) { XB_SPIN(xb_ld(&bar[XB_TOPGEN]) == g, bar); __builtin_amdgcn_fence(__ATOMIC_ACQUIRE, "agent"); xb_add(&bar[XB_XGEN(b.x)], 1u); asm volatile("s_waitcnt vmcnt(0)" ::: "memory"); }
        else { XB_SPIN(xb_ld(&bar[XB_XGEN(b.x)]) == g, bar); __builtin_amdgcn_fence(__ATOMIC_ACQUIRE, "agent"); asm volatile("s_waitcnt vmcnt(0)" ::: "memory"); }
    }
    __syncthreads();
}

__device__ __forceinline__ void quad_barrier(unsigned* cnt, unsigned* tmo, unsigned same_xcd) {
    asm volatile("s_waitcnt vmcnt(0)" ::: "memory");
    __syncthreads();
    if (threadIdx.x == 0) {
        if (!same_xcd) { __builtin_amdgcn_fence(__ATOMIC_RELEASE, "agent"); asm volatile("s_waitcnt vmcnt(0)" ::: "memory"); }
        const unsigned old = xb_add(cnt, 1u);
        const unsigned target = (old / 4u + 1u) * 4u;
        XB_SPIN(xb_ld(cnt) < target, tmo);
        __builtin_amdgcn_fence(__ATOMIC_ACQUIRE, "agent");
        asm volatile("s_waitcnt vmcnt(0)" ::: "memory");
    }
    __syncthreads();
}

__device__ __forceinline__ void group_barrier(unsigned* cnt, unsigned* tmo, unsigned same, unsigned n) {
    asm volatile("s_waitcnt vmcnt(0)" ::: "memory");
    __syncthreads();
    if (threadIdx.x == 0) {
        if (!same) { __builtin_amdgcn_fence(__ATOMIC_RELEASE, "agent"); asm volatile("s_waitcnt vmcnt(0)" ::: "memory"); }
        const unsigned old = xb_add(cnt, 1u);
        const unsigned target = (old / n + 1u) * n;
        XB_SPIN(xb_ld(cnt) < target, tmo);
        __builtin_amdgcn_fence(__ATOMIC_ACQUIRE, "agent");
        asm volatile("s_waitcnt vmcnt(0)" ::: "memory");
    }
    __syncthreads();
}
__device__ __forceinline__ void group_arrive(unsigned* cnt, unsigned same, unsigned n, volatile LAS unsigned* st) {
    asm volatile("s_waitcnt vmcnt(0)" ::: "memory");
    __syncthreads();
    if (threadIdx.x == 0) {
        if (!same) { __builtin_amdgcn_fence(__ATOMIC_RELEASE, "agent"); asm volatile("s_waitcnt vmcnt(0)" ::: "memory"); }
        const unsigned old = xb_add(cnt, 1u);
        st[0] = (old / n + 1u) * n;
    }
}
__device__ __forceinline__ void group_wait(unsigned* cnt, unsigned* tmo, volatile LAS unsigned* st) {
    if (threadIdx.x == 0) {
        const unsigned target = st[0];
        XB_SPIN(xb_ld(cnt) < target, tmo);
        __builtin_amdgcn_fence(__ATOMIC_ACQUIRE, "agent");
        asm volatile("s_waitcnt vmcnt(0)" ::: "memory");
    }
    __syncthreads();
}
#ifndef CFG_ALIGN
#define CFG_ALIGN true
#endif
#ifndef CFG_ALIGN1
#define CFG_ALIGN1 true
#endif
#ifndef CFG_SP2
#define CFG_SP2 true
#endif
#ifndef PROBE_MASK
#define PROBE_MASK 0
#endif
constexpr size_t MiB = 1u << 20;
constexpr size_t WS_CTL = 0, CTL_ZERO_BYTES = 3 * MiB, WS_SSQ = 1 * MiB, WS_WLR = 2 * MiB + 512 * 1024;
constexpr size_t WS_WIN = 3 * MiB, WS_WBR = 14 * MiB, WS_WO = 16 * MiB, WS_WUP = 18 * MiB, WS_WDN = 26 * MiB;
constexpr size_t WS_XN = 35 * MiB, WS_PROJ = 67 * MiB, WS_DSS = 243 * MiB, WS_DT = 251 * MiB, WS_OI = 259 * MiB, WS_END = 291 * MiB;
static_assert(WS_WIN - WS_WLR == WOF_IN * 2 && WS_WBR - WS_WLR == WOF_BR * 2 && WS_WO - WS_WLR == WOF_O * 2 && WS_WUP - WS_WLR == WOF_UP * 2 && WS_WDN - WS_WLR == WOF_DN * 2, "weight offsets");
static_assert((size_t)NIN * DM * 2 <= WS_WBR - WS_WIN && (size_t)M * DM * 2 <= WS_PROJ - WS_XN && (size_t)(M / 256) * PBE * 2 <= WS_DSS - WS_PROJ && 256 * LDH <= PBE && (size_t)NUNIT * 8192 * 2 <= WS_DT - WS_DSS && (size_t)NUNIT * 64 * 4 <= WS_OI - WS_DT && (size_t)NITEM * 8192 * 4 <= WS_END - WS_OI && (size_t)9 * M * 8 <= 2 * MiB && WS_WDN + (size_t)DM * LDH * 2 <= WS_XN, "d_ws map");
constexpr int CW_BAR = 4096;
constexpr int CW_QUAD = 16384, CW_XCC = 32768, CW_BATCH = 24576;
constexpr int RS_OFF = 131072;
constexpr int RING_BYTES = 147456, MISC_OFF = RING_BYTES + 320, LDS_BYTES = RING_BYTES + 1024;
static_assert(ATT_END <= RING_BYTES && GA_END <= RING_BYTES && GB_END <= RING_BYTES && LR_END <= RING_BYTES && pg8::STAGE_BYTES <= RING_BYTES && NW * CONV_SCR <= RING_BYTES, "LDS map");

struct MergeOrder {
    pg8::StaticOrder so;
    __device__ __forceinline__ bool next(int i, pg8::Unit& u) const { pg8::Unit v; if (!so.next(i >> 1, v)) return false; const int br = i & 1; u.pm = v.pm + br * (M / 256); u.pn = v.pn + br * 4; return true; }
    __device__ __forceinline__ void a_ready(const pg8::Unit&) const {}
    __device__ __forceinline__ void done(const pg8::Unit&) const {}
};

__device__ __forceinline__ int lane_id() { int l; asm volatile("v_mbcnt_lo_u32_b32 %0, -1, 0\n\tv_mbcnt_hi_u32_b32 %0, -1, %0" : "=v"(l)); return l; }
struct Args { const float* in[13]; float* out; unsigned char* ws; };

__global__ void __launch_bounds__(NT, 2) mega_fwd(Args a) {
    extern __shared__ __attribute__((aligned(16))) unsigned char lds_raw[];
    LAS unsigned char* lds = (LAS unsigned char*)lds_raw;
    const int tid0 = threadIdx.x, lane0 = tid0 & 63, wave = __builtin_amdgcn_readfirstlane(tid0 >> 6);
    const int G = gridDim.x, bx0 = blockIdx.x, vcu0 = (G % 8 == 0) ? (bx0 % 8) * (G / 8) + bx0 / 8 : bx0;
    const int ngw = G * NW;
    for (int u = tid0; u < (LDS_BYTES - RING_BYTES) / 4; u += NT) ((LAS unsigned*)(lds + RING_BYTES))[u] = 0u;
    __syncthreads();
    unsigned char* ws = a.ws;
    Ptrs P;
    P.x = a.in[0]; P.mix_g = a.in[1]; P.w_in = a.in[2]; P.relb = a.in[3]; P.wglr = a.in[4]; P.bgate = a.in[5]; P.gng = a.in[6]; P.wbr = a.in[7]; P.wout = a.in[8]; P.mlp_g = a.in[9]; P.wup = a.in[10]; P.wdn = a.in[11]; P.fin_g = a.in[12];
    P.res = a.out;
    P.wts = (bf16_t*)(ws + WS_WLR); P.XN = (bf16_t*)(ws + WS_XN); P.proj = (bf16_t*)(ws + WS_PROJ);
    P.DSS = (bf16_t*)(ws + WS_DSS); P.DT = (float*)(ws + WS_DT); P.OI = (float*)(ws + WS_OI); P.SSQ = (unsigned long long*)(ws + WS_SSQ);
    XcdBarrier bar = xcd_barrier_post((unsigned*)(ws + WS_CTL) + CW_BAR, (volatile LAS unsigned*)(lds + MISC_OFF) + 8);
    LAS float* scr = (LAS float*)(lds + wave * CONV_SCR);
    unsigned* ctlw = (unsigned*)(ws + WS_CTL);
    const int pm0 = 8 * (bx0 % 8) + (bx0 / 8) % 8, pn0 = bx0 / 64;
    const bool quad_ok = (G == 256);
    if (tid0 == 0) __hip_atomic_store(ctlw + CW_XCC + bx0, bar.x + 1u, __ATOMIC_RELAXED, __HIP_MEMORY_SCOPE_AGENT);
    volatile LAS unsigned* qflag = (volatile LAS unsigned*)(lds + MISC_OFF) + 16;

    if (PROBE_MASK & 128) phase_x0(P, vcu0 * NW + wave, ngw, lane0);
    phase_x0(P, vcu0 * NW + wave, ngw, lane0);
    conv_phase(P, -1, 0, scr, vcu0 * NW + wave, ngw, lane0);
    xcd_barrier(bar);
    if (tid0 == 0) { unsigned same = quad_ok ? 1u : 0u; const unsigned me = __hip_atomic_load(ctlw + CW_XCC + bx0, __ATOMIC_RELAXED, __HIP_MEMORY_SCOPE_AGENT);
        for (int q = 0; q < 4; ++q) if (__hip_atomic_load(ctlw + CW_XCC + (bx0 % 64) + 64 * q, __ATOMIC_RELAXED, __HIP_MEMORY_SCOPE_AGENT) != me) same = 0u;
        unsigned sameb = quad_ok ? 1u : 0u;
        for (int q = 0; q < 32; ++q) if (__hip_atomic_load(ctlw + CW_XCC + (bx0 % 8) + 8 * q, __ATOMIC_RELAXED, __HIP_MEMORY_SCOPE_AGENT) != me) sameb = 0u;
        qflag[0] = same; qflag[1] = sameb; }
    __syncthreads();
    const unsigned same_xcd = qflag[0], same_batch = qflag[1];
    unsigned* bcnt = ctlw + CW_BATCH + 64 * (bx0 % 8);
    volatile LAS unsigned* bst = (volatile LAS unsigned*)(lds + MISC_OFF) + 20;
    unsigned* qcnt = ctlw + CW_QUAD + 64 * pm0; unsigned* qtmo = (unsigned*)(ws + WS_CTL) + CW_BAR;
#define SEAM(q) do { if ((q) && quad_ok) quad_barrier(qcnt, qtmo, same_xcd); else xcd_barrier(bar); } while (0)
#pragma unroll 1
    for (int l = 0; l < DEPTH; ++l) {
        int bx = bx0, vcu = vcu0, lane = lane_id(), pm = pm0, pn = pn0; OPAQUE_S(bx); OPAQUE_S(vcu); OPAQUE_V(lane); OPAQUE_S(pm); OPAQUE_S(pn);
        const int gw = vcu * NW + wave;
        {
            if (quad_ok) { if (PROBE_MASK & 8192) lr_item(P, l, lds, 4 * pm + pn); lr_item(P, l, lds, 4 * pm + pn); }
            else for (int u = vcu; u < BATCH * NCH; u += G) lr_item(P, l, lds, u);
            pg8::Gemm g{P.XN, P.Win_t(), M, NIN, DM, DM, DM, (size_t)256 * DM * 2, 1 << 30, 0}; pg8::StaticOrder S; S.init(M, NIN, G, bx);
            pg8::Unit u0; S.next(0, u0); LAS float* rsl = (LAS float*)(lds + RS_OFF);
            int tid1 = wave * 64 + lane_id(); OPAQUE_V(tid1);
            if (tid1 < 256) rsl[tid1] = ssq_rstd(P.SSQ[(size_t)(2 * l) * M + u0.pm * 256 + tid1]);
            __syncthreads();
            EpiIn E{P, P.SSQ + (size_t)(2 * l) * M, rsl, u0.pm};
            if (PROBE_MASK & 1) { pg8::gemm_phase<EpiIn, pg8::StaticOrder, CFG_ALIGN, CFG_SP2>(lds, g, S, E); __syncthreads(); }
            pg8::gemm_phase<EpiIn, pg8::StaticOrder, CFG_ALIGN, CFG_SP2>(lds, g, S, E);
        }
        if (quad_ok) { xcd_barrier_arrive(bar); group_barrier(bcnt, qtmo, same_batch, 32u); }
        else xcd_barrier(bar);
        {
            if (quad_ok) { if (PROBE_MASK & 2) gla_a_unit<false>(P, lds, (((pm >> 3) * 4 + pn) * NSC) + (pm & 7)); gla_a_unit(P, lds, (((pm >> 3) * 4 + pn) * NSC) + (pm & 7)); }
            else for (int u = vcu; u < NUNIT; u += G) gla_a_unit(P, lds, u);
            if (quad_ok) xcd_barrier_wait(bar);
            if (PROBE_MASK & 8) conv_phase(P, l, l + 1, scr, gw, ngw, lane);
            conv_phase(P, l, l + 1, scr, gw, ngw, lane);
            xcd_barrier_arrive(bar);
            if (quad_ok) { for (int hg = 0; hg < 2; ++hg) { if (PROBE_MASK & 4) att_unit<false>(P, l, lds, pm >> 3, 4 * (pm & 7) + pn, hg); att_unit(P, l, lds, pm >> 3, 4 * (pm & 7) + pn, hg); } }
            else for (int u = vcu; u < BATCH * NCH * 2; u += G) { const int c = u % NCH, bh = u / NCH; att_unit(P, l, lds, bh >> 1, c, bh & 1); }
            xcd_barrier_wait(bar);
            if (quad_ok) group_arrive(bcnt, same_batch, 32u, bst); else xcd_barrier_arrive(bar);
            if (quad_ok) { if (PROBE_MASK & 16) gla_b_unit(P, l, lds, (((pm >> 3) * 4 + pn) * NSC) + (pm & 7)); gla_b_unit(P, l, lds, (((pm >> 3) * 4 + pn) * NSC) + (pm & 7)); }
            else for (int u = vcu; u < NUNIT; u += G) gla_b_unit(P, l, lds, u);
            if (quad_ok) group_wait(bcnt, qtmo, bst); else xcd_barrier_wait(bar);
        }
        SEAM(1);
        {
            pg8::Gemm g{P.QA(), P.Wbr_t(), 2 * M, 2048, 512, 512, 512, (size_t)PBE * 2, M / 256, (size_t)(O_VB - O_QA) * 2};     MergeOrder S; S.so.init(M, DM, G, bx);
            EpiMerge E{P};
            if (PROBE_MASK & 32) { pg8::gemm_phase<EpiMerge, MergeOrder, CFG_ALIGN, CFG_SP2>(lds, g, S, E); __syncthreads(); }
            pg8::gemm_phase<EpiMerge, MergeOrder, CFG_ALIGN, CFG_SP2>(lds, g, S, E);
        }
        SEAM(1);
        {
            pg8::Gemm g{P.MERGED(), P.Wo_t(), M, DM, DM, DM, DM, (size_t)PBE * 2, 1 << 30, 0}; pg8::StaticOrder S; S.init(M, DM, G, bx);
            EpiRes E{P, P.SSQ + (size_t)(2 * l + 1) * M};
            pg8::gemm_phase<EpiRes, pg8::StaticOrder, CFG_ALIGN1, CFG_SP2>(lds, g, S, E);
        }
        SEAM(1);
        {
            pg8::Gemm g{P.XN, P.Wup_t(), M, DFF, DM, DM, DM, (size_t)256 * DM * 2, 1 << 30, 0}; pg8::StaticOrder S; S.init(M, DFF, G, bx);
            pg8::Unit u0; S.next(0, u0); LAS float* rsl = (LAS float*)(lds + RS_OFF);
            int tid5 = wave * 64 + lane_id(); OPAQUE_V(tid5);
            if (tid5 < 256) rsl[tid5] = ssq_rstd(P.SSQ[(size_t)(2 * l + 1) * M + u0.pm * 256 + tid5]);
            __syncthreads();
            EpiUp E{P, P.SSQ + (size_t)(2 * l + 1) * M, rsl, u0.pm};
            if (PROBE_MASK & 64) { pg8::gemm_phase<EpiUp, pg8::StaticOrder, CFG_ALIGN, CFG_SP2>(lds, g, S, E); __syncthreads(); }
            pg8::gemm_phase<EpiUp, pg8::StaticOrder, CFG_ALIGN, CFG_SP2>(lds, g, S, E);
        }
        SEAM(1);
        {
            pg8::Gemm g{P.HID(), P.Wdn_t(), M, DM, DFF, LDH, LDH, (size_t)PBE * 2, 1 << 30, 0}; pg8::StaticOrder S; S.init(M, DM, G, bx);
            EpiRes E{P, P.SSQ + (size_t)(2 * l + 2) * M};
            pg8::gemm_phase<EpiRes, pg8::StaticOrder, CFG_ALIGN1, CFG_SP2>(lds, g, S, E);
        }
        SEAM(1);
    }
    int lane_f = lane_id(), pmf = pm0; OPAQUE_V(lane_f); OPAQUE_S(pmf);
    if (quad_ok) phase_final(P, pmf * 256 + pn0 * 64 + wave, pmf * 256 + pn0 * 64 + 64, NW, lane_f);
    else phase_final(P, vcu0 * NW + wave, M, ngw, lane_f);
#undef SEAM
}

extern "C" void kernel_launch(void* const* d_in, const int* in_sizes, int n_in, void* d_out, int out_size, void* d_ws, size_t ws_size, hipStream_t stream) {
    static int grid = 0;
    if (grid == 0) {
        if (n_in != 13 || out_size != M * DM || ws_size < WS_END) { fprintf(stderr, "kernel_launch: unexpected shapes (n_in %d, out %d, ws %zu < %zu)\n", n_in, out_size, ws_size, (size_t)WS_END); grid = -1; return; }
        int dev = 0, cus = 0, per_cu = 0;
        if (hipGetDevice(&dev) != hipSuccess || hipDeviceGetAttribute(&cus, hipDeviceAttributeMultiprocessorCount, dev) != hipSuccess) { grid = -1; return; }
        if (hipFuncSetAttribute((const void*)mega_fwd, hipFuncAttributeMaxDynamicSharedMemorySize, LDS_BYTES) != hipSuccess) { fprintf(stderr, "kernel_launch: hipFuncSetAttribute failed\n"); grid = -1; return; }
        if (hipOccupancyMaxActiveBlocksPerMultiprocessor(&per_cu, (const void*)mega_fwd, NT, LDS_BYTES) != hipSuccess || per_cu < 1) fprintf(stderr, "kernel_launch: occupancy query says %d blocks/CU\n", per_cu);
        (void)hipGetLastError();
        grid = cus;
    }
    if (grid < 0) return;
    (void)hipMemsetAsync((char*)d_ws + WS_CTL, 0, CTL_ZERO_BYTES, stream);
    Args a{};
    for (int i = 0; i < 13; ++i) a.in[i] = (const float*)d_in[i];
    a.out = (float*)d_out; a.ws = (unsigned char*)d_ws;
    hipLaunchKernelGGL(mega_fwd, dim3(grid), dim3(NT), LDS_BYTES, stream, a);
}
```

```cpp
#include <hip/hip_runtime.h>
#include <cstdio>
#include <cstdint>
#ifndef CFG_BATCH
#define CFG_BATCH 8
#endif
#ifndef CFG_SEQ
#define CFG_SEQ 2048
#endif
constexpr int BATCH = CFG_BATCH, SEQ = CFG_SEQ, DM = 1024, DEPTH = 4, NCH = SEQ / 64, M = BATCH * SEQ;
constexpr int O_QA = 0, O_VB = O_QA + 256 * 512, O_KA = O_VB + 256 * 512, O_VA = O_KA + 256 * 512, O_QB = O_VA + 256 * 512, O_KB = O_QB + 256 * 256, O_RB = O_KB + 256 * 256, O_LA = O_RB + 256 * 512,
              O_GA = O_LA + 256 * 512  , O_GB = O_GA + 256 * 1024, PBE = O_GB + 256 * 1024;
constexpr int LDH = 4096 + 64;
constexpr int NREL = 257, DFF = 4096, INC = 5136, NIN = 5120;
constexpr int NITEM = BATCH * NCH * 4;
constexpr float EPS = 1e-6f, LOG2E = 1.4426950408889634f, LN2 = 0.6931471805599453f;
constexpr int NW = 8, NT = 512;

typedef unsigned short bf16_t;
typedef unsigned u32x2 __attribute__((ext_vector_type(2)));
typedef unsigned u32x4 __attribute__((ext_vector_type(4)));
typedef float f32x2 __attribute__((ext_vector_type(2)));

#ifdef EMU
#define DEV inline
#define LAS
#define MFMA32(a, b, c) emu_mfma32(a, b, c)
#define MFMA16(a, b, c) emu_mfma16(a, b, c)
#define SHFL_XOR(v, m) emu_shfl_xor(v, m)
#define TR_READ(p) emu_tr_read((const void*)(p))
#define WAVE_LDS_SYNC() emu::wave_sync()
#define EXP2F(x) exp2f(x)
#define LOG2F(x) log2f(x)
#define RCPF(x) (1.0f / (x))
#define RSQF(x) (1.0f / sqrtf(x))
#define ATOMIC_ADD_U64(p, v) (*(p) += (v))
#define OPAQUE_V(x)
#define OPAQUE_S(x)
#define SCHED_FENCE()
#define BPERM(srclane, v) emu_shfl((v), (srclane))
#define DPP_SHR_F(v, n) emu_row_shr((v), (n))
#define ADD_INPLACE(x, y) ((x) += (y))
#define NT_LOAD_F4(p) (*(const f32x4*)(p))
#define NT_STORE_F4(p, v) (*(f32x4*)(p) = (v))
#define WAVE_ANY(c) emu_wave_any(c)
#define ST16_WT(p, v) (*(u32x4*)(p) = (v))
DEV unsigned cvtpk(float lo, float hi) { auto f = [](float x) { unsigned u; memcpy(&u, &x, 4); return (u + 0x7fffu + ((u >> 16) & 1u)) >> 16; }; return f(lo) | (f(hi) << 16); }
#else
#define DEV __device__ __forceinline__
#define LAS __attribute__((address_space(3)))
typedef short bf16x8 __attribute__((ext_vector_type(8)));
typedef short s16x4 __attribute__((ext_vector_type(4)));
typedef float f32x16 __attribute__((ext_vector_type(16)));
typedef float f32x4 __attribute__((ext_vector_type(4)));
typedef short v4i16_t __attribute__((ext_vector_type(4)));
typedef __bf16 bf16x2_t __attribute__((ext_vector_type(2)));
#define MFMA32(a, b, c) __builtin_amdgcn_mfma_f32_32x32x16_bf16(a, b, c, 0, 0, 0)
#define MFMA16(a, b, c) __builtin_amdgcn_mfma_f32_16x16x32_bf16(a, b, c, 0, 0, 0)
#define SHFL_XOR(v, m) __shfl_xor(v, m)
#define TR_READ(p) __builtin_bit_cast(s16x4, __builtin_amdgcn_ds_read_tr16_b64_v4i16((LAS v4i16_t*)(p)))
#define WAVE_LDS_SYNC() asm volatile("s_waitcnt lgkmcnt(0)" ::: "memory")
#define EXP2F(x) __builtin_amdgcn_exp2f(x)
#define LOG2F(x) __builtin_amdgcn_logf(x)
#define RCPF(x) __builtin_amdgcn_rcpf(x)
#define RSQF(x) __builtin_amdgcn_rsqf(x)
#define ATOMIC_ADD_U64(p, v) atomicAdd((p), (v))
#define OPAQUE_V(x) asm volatile("" : "+v"(x))
#define OPAQUE_S(x) asm volatile("" : "+s"(x))
#define BPERM(srclane, v) ((unsigned)__builtin_amdgcn_ds_bpermute((srclane) * 4, (int)(v)))
#define DPP_SHR_F(v, n) __builtin_bit_cast(float, __builtin_amdgcn_update_dpp(0, __builtin_bit_cast(int, (float)(v)), 0x110 + (n), 0xf, 0xf, true))
#define ADD_INPLACE(x, y) asm("v_add_f32_e32 %0, %1, %0" : "+v"(x) : "v"(y))
#define NT_LOAD_F4(p) __builtin_nontemporal_load((const f32x4*)(p))
#define NT_STORE_F4(p, v) __builtin_nontemporal_store((v), (f32x4*)(p))
#define WAVE_ANY(c) (__builtin_amdgcn_ballot_w64(c) != 0ull)
#define SCHED_FENCE() __builtin_amdgcn_sched_barrier(0)
#define ST16_WT(p, v) (*(u32x4*)(p) = (v))
DEV unsigned cvtpk(float lo, float hi) { f32x2 v = {lo, hi}; bf16x2_t b = __builtin_convertvector(v, bf16x2_t); return __builtin_bit_cast(unsigned, b); }
#endif
typedef LAS unsigned char* lds_t;
DEV size_t pofs(size_t row, int ld) { return (row >> 8) * (size_t)PBE + (row & 255) * (size_t)ld; }
DEV size_t pofs_f(size_t row, int ld) { return (row >> 8) * (size_t)(PBE / 2) + (row & 255) * (size_t)ld; }

DEV float bf2f(bf16_t b) { return __builtin_bit_cast(float, (unsigned)b << 16); }
DEV float bflo(unsigned u) { return __builtin_bit_cast(float, u << 16); }
DEV float bfhi(unsigned u) { return __builtin_bit_cast(float, u & 0xffff0000u); }
DEV int crow(int r, int hi) { return (r & 3) + 8 * (r >> 2) + 4 * hi; }
constexpr float SSQ_SCALE = 16777216.0f, SSQ_INV = 1.0f / 16777216.0f;
DEV float ssq_rstd(unsigned long long v) { return RSQF((float)v * (SSQ_INV / DM) + EPS); }
DEV u32x4 pack8(const f32x4 a, const f32x4 b) { u32x4 w; w[0] = cvtpk(a[0], a[1]); w[1] = cvtpk(a[2], a[3]); w[2] = cvtpk(b[0], b[1]); w[3] = cvtpk(b[2], b[3]); return w; }
DEV void unpack8(const u32x4 w, f32x4& a, f32x4& b) { a[0] = bflo(w[0]); a[1] = bfhi(w[0]); a[2] = bflo(w[1]); a[3] = bfhi(w[1]); b[0] = bflo(w[2]); b[1] = bfhi(w[2]); b[2] = bflo(w[3]); b[3] = bfhi(w[3]); }
DEV u32x4 quad_rows(const u32x4 w, int lane) { const int src = (lane >> 2) + 16 * (lane & 3); u32x4 r; r[0] = BPERM(src, w[0]); r[1] = BPERM(src, w[1]); r[2] = BPERM(src, w[2]); r[3] = BPERM(src, w[3]); return r; }
DEV float bperm_f(int src, float v) { return __builtin_bit_cast(float, BPERM(src, __builtin_bit_cast(unsigned, v))); }
DEV f32x4 quad_rows_f(const f32x4 w, int lane) { const int src = (lane >> 2) + 16 * (lane & 3); f32x4 r; r[0] = bperm_f(src, w[0]); r[1] = bperm_f(src, w[1]); r[2] = bperm_f(src, w[2]); r[3] = bperm_f(src, w[3]); return r; }
DEV float sigmoidf_(float v) { return RCPF(1.0f + EXP2F(-v * LOG2E)); }

constexpr size_t WOF_LR = 0, WOF_IN = 256 * 1024, WOF_BR = WOF_IN + (size_t)11 * 512 * 1024, WOF_O = WOF_BR + (size_t)2 * 512 * 1024, WOF_UP = WOF_O + (size_t)2 * 512 * 1024, WOF_DN = WOF_UP + (size_t)8 * 512 * 1024;
struct Ptrs {
    const float *x, *mix_g, *w_in, *relb, *wglr, *bgate, *gng, *wbr, *wout, *mlp_g, *wup, *wdn, *fin_g;
    float* res;
    bf16_t *proj, *wts, *XN, *DSS; float *OI, *DT; unsigned long long* SSQ;
    DEV bf16_t* QA() const { return proj + O_QA; } DEV bf16_t* VB() const { return proj + O_VB; } DEV bf16_t* KA() const { return proj + O_KA; } DEV bf16_t* VA() const { return proj + O_VA; }
    DEV bf16_t* QB() const { return proj + O_QB; } DEV bf16_t* KB() const { return proj + O_KB; } DEV bf16_t* RB() const { return proj + O_RB; } DEV bf16_t* LA() const { return proj + O_LA; }
    DEV bf16_t* GA() const { return proj + O_GA; } DEV bf16_t* GB() const { return proj + O_GB; } DEV bf16_t* T() const { return proj + O_KA; } DEV bf16_t* MERGED() const { return proj + O_QB; } DEV bf16_t* HID() const { return proj; }
    DEV bf16_t* Wlr_t() const { return wts + WOF_LR; } DEV bf16_t* Win_t() const { return wts + WOF_IN; } DEV bf16_t* Wbr_t() const { return wts + WOF_BR; } DEV bf16_t* Wo_t() const { return wts + WOF_O; }
    DEV bf16_t* Wup_t() const { return wts + WOF_UP; } DEV bf16_t* Wdn_t() const { return wts + WOF_DN; }
};

constexpr int ATT_KSTR = 528, ATT_VSTR = 576, ATT_KT = 64 * ATT_KSTR, ATT_VT = 64 * ATT_VSTR;
constexpr int ATT_K0 = 0, ATT_V0 = 2 * ATT_KT, ATT_BT = ATT_V0 + 2 * ATT_VT, ATT_END = ATT_BT + 4 * 260 * 4;
constexpr int G1_QSTR = 144, G1_ESTR = 192, G1_VSTR = 320;
constexpr int G1_QT = 0, G1_KT = G1_QT + 64 * G1_QSTR, G1_KE = G1_KT + 64 * G1_QSTR, G1_V = G1_KE + 64 * G1_ESTR, G1_TOT = G1_V + 64 * G1_VSTR, G1_END = G1_TOT + 8 * 64 * 4;
constexpr int CONV_SCR = 64 * 33 * 4;

DEV void phase_x0(const Ptrs& P, int gw, int ngw, int lane) {
    for (int row = gw; row < M; row += ngw) {
        const f32x4* xr = (const f32x4*)(P.x + (size_t)row * DM); u32x2* xn = (u32x2*)(P.XN + (size_t)row * DM);
        float s = 0.f;
#pragma unroll
        for (int j = 0; j < 4; ++j) { const f32x4 v = NT_LOAD_F4(xr + lane + 64 * j); s += (v[0] * v[0] + v[1] * v[1]) + (v[2] * v[2] + v[3] * v[3]);
            u32x2 o; o[0] = cvtpk(v[0], v[1]); o[1] = cvtpk(v[2], v[3]); xn[lane + 64 * j] = o; }
#pragma unroll
        for (int o = 1; o < 64; o <<= 1) s += SHFL_XOR(s, o);
        if (lane == 0) P.SSQ[row] = (unsigned long long)(s * SSQ_SCALE);
    }
}

DEV void phase_final(const Ptrs& P, int row_first, int row_end, int row_step, int lane) {
    const unsigned long long* ssq = P.SSQ + (size_t)8 * M;
    for (int row = row_first; row < row_end; row += row_step) {
        f32x4* rr = (f32x4*)(P.res + (size_t)row * DM); const f32x4* g = (const f32x4*)P.fin_g; const u32x2* xn = (const u32x2*)(P.XN + (size_t)row * DM);
        const float rs = ssq_rstd(ssq[row]);
#pragma unroll
        for (int j = 0; j < 4; ++j) { const u32x2 w = xn[lane + 64 * j]; f32x4 v = {bflo(w[0]), bfhi(w[0]), bflo(w[1]), bfhi(w[1])}; const f32x4 gg = g[lane + 64 * j]; v = v * rs * gg; NT_STORE_F4(rr + lane + 64 * j, v); }
    }
}

struct ConvD { const float* W; bf16_t* WT; const float* gain; float scale; int ldw, K, ldt, k0, n0, gate; };
DEV ConvD conv_decode(const Ptrs& P, int lrest, int lin, int n_rest, int n_in, int it) {
    ConvD d; int r = it, nblk; d.gain = nullptr; d.scale = 1.f; d.gate = 0;
    if (r < n_rest) {
        if (r < 256) { d.W = P.wbr + (size_t)(2 * lrest) * 512 * DM; d.ldw = DM; d.K = 512; nblk = 32; d.WT = P.Wbr_t(); }
        else if (r < 512) { r -= 256; d.W = P.wbr + (size_t)(2 * lrest + 1) * 512 * DM; d.ldw = DM; d.K = 512; nblk = 32; d.WT = P.Wbr_t() + (size_t)DM * 512; }
        else if (r < 1024) { r -= 512; d.W = P.wout + (size_t)lrest * DM * DM; d.ldw = DM; d.K = DM; nblk = 32; d.WT = P.Wo_t(); }
        else if (r < 3072) { r -= 1024; d.W = P.wup + (size_t)lrest * DM * DFF; d.ldw = DFF; d.K = DM; nblk = 128; d.WT = P.Wup_t(); d.gain = P.mlp_g + lrest * DM; }
        else { r -= 3072; d.W = P.wdn + (size_t)lrest * DFF * DM; d.ldw = DM; d.K = DFF; nblk = 32; d.WT = P.Wdn_t(); }
    } else {
        r -= n_rest; const float* W0 = P.w_in + (size_t)lin * DM * INC; d.gain = P.mix_g + lin * DM; d.ldw = INC; d.K = DM; d.W = W0; d.WT = P.Win_t(); nblk = 1;
        if (r >= n_in) { d.gate = 1; r -= n_in; }
        else if (r < 256) { nblk = 16; d.scale = 0.125f * LOG2E; }
        else if (r < 768) { r -= 256; d.W = W0 + 512; nblk = 32; d.WT = P.Win_t() + (size_t)512 * DM; }
        else if (r < 896) { r -= 768; d.W = W0 + 1536; nblk = 8; d.WT = P.Win_t() + (size_t)1536 * DM; d.scale = 0.125f; }
        else if (r < 1536) { r -= 896; d.W = W0 + 1792; nblk = 40; d.WT = P.Win_t() + (size_t)1792 * DM; }
        else { r -= 1536; d.W = W0 + 3088; nblk = 64; d.WT = P.Win_t() + (size_t)3072 * DM; }
    }
    d.ldt = d.K == DFF ? LDH : d.K;
    if (d.gate) { d.k0 = r; d.n0 = 0; } else { d.k0 = 64 * (r / nblk); d.n0 = 32 * (r % nblk); }
    return d;
}
DEV void conv_load(const ConvD& d, f32x4 (&v)[8], int lane) {
    const float* src = d.W + (size_t)(d.k0 + (lane >> 3)) * d.ldw + d.n0 + 4 * (lane & 7);
#pragma unroll
    for (int i = 0; i < 8; ++i) v[i] = NT_LOAD_F4(src + (size_t)(8 * i) * d.ldw);
}
DEV void conv_finish(const ConvD& d, const f32x4 (&v)[8], LAS float* scr, int lane) {
#pragma unroll
    for (int i = 0; i < 8; ++i) { const int kk = 8 * i + (lane >> 3); const float g = d.gain ? d.gain[d.k0 + kk] * d.scale : d.scale; LAS float* s = scr + kk * 33 + 4 * (lane & 7);
        s[0] = v[i][0] * g; s[1] = v[i][1] * g; s[2] = v[i][2] * g; s[3] = v[i][3] * g; }
    WAVE_LDS_SYNC();
    const int c = lane & 7;
#pragma unroll
    for (int j = 0; j < 4; ++j) { const int n = (lane >> 3) + 8 * j; const LAS float* s = scr + (8 * c) * 33 + n;
        u32x4 o; o[0] = cvtpk(s[0 * 33], s[1 * 33]); o[1] = cvtpk(s[2 * 33], s[3 * 33]); o[2] = cvtpk(s[4 * 33], s[5 * 33]); o[3] = cvtpk(s[6 * 33], s[7 * 33]);
        *(u32x4*)(d.WT + (size_t)(d.n0 + n) * d.ldt + d.k0 + 8 * c) = o; }
    WAVE_LDS_SYNC();
}
DEV void conv_lr_item(const float* w_in_l, const float* gain, bf16_t* Wlr_t, int it, int lane) {
#pragma unroll 1
    for (int j = 0; j < 4; ++j) { const int k = it * 256 + j * 64 + lane; const float g = gain[k]; const f32x4* src = (const f32x4*)(w_in_l + (size_t)k * INC + 3072);
#pragma unroll
        for (int q = 0; q < 4; ++q) { const f32x4 v = src[q];
#pragma unroll
            for (int e = 0; e < 4; ++e) Wlr_t[(size_t)(4 * q + e) * DM + k] = (bf16_t)(cvtpk(v[e] * g, 0.f) & 0xffffu); } }
}
DEV void conv_phase(const Ptrs& P, int lrest, int lin, LAS float* scr, int gw, int ngw, int lane) {
    const int n_rest = lrest >= 0 ? 5120 : 0, n_in = lin < DEPTH ? 2560 : 0, total = n_rest + n_in + (lin < DEPTH ? 4 : 0);
    int it = gw; if (it >= total) return;
    ConvD d = conv_decode(P, lrest, lin, n_rest, n_in, it); f32x4 v[8];
    if (!d.gate) conv_load(d, v, lane);
#pragma unroll 1
    for (;;) {
        const int itn = it + ngw; const bool more = itn < total; ConvD dn = d; f32x4 vn[8];
        if (more) { dn = conv_decode(P, lrest, lin, n_rest, n_in, itn); if (!dn.gate) conv_load(dn, vn, lane); }
        if (d.gate) conv_lr_item(d.W, d.gain, P.Wlr_t(), d.k0, lane); else conv_finish(d, v, scr, lane);
        if (!more) break;
        d = dn; it = itn;
#pragma unroll
        for (int i = 0; i < 8; ++i) v[i] = vn[i];
    }
}

constexpr int LR_PART = 0, LR_LRB = 8 * 64 * 16 * 4, LR_END = LR_LRB + 64 * 16 * 4;
DEV void lr_item(const Ptrs& P, int layer, lds_t lds, int bc) {
    int tid_ = threadIdx.x; OPAQUE_V(tid_); const int tid = tid_, lane = tid & 63, w = tid >> 6, l15 = lane & 15, lq = lane >> 4;
    const size_t row0 = (size_t)bc * 64;
    f32x4 acc[4];
#pragma unroll
    for (int m = 0; m < 4; ++m) acc[m] = (f32x4){0.f, 0.f, 0.f, 0.f};
#pragma unroll
    for (int ks = 0; ks < 4; ++ks) { const int k = 128 * w + 32 * ks + 8 * lq;
        const bf16x8 b = *(const bf16x8*)(P.Wlr_t() + (size_t)l15 * DM + k);
#pragma unroll
        for (int m = 0; m < 4; ++m) { const bf16x8 a = *(const bf16x8*)(P.XN + (row0 + 16 * m + l15) * DM + k); acc[m] = MFMA16(a, b, acc[m]); } }
    LAS float* part = (LAS float*)(lds + LR_PART); LAS float* lrb = (LAS float*)(lds + LR_LRB);
#pragma unroll
    for (int m = 0; m < 4; ++m)
#pragma unroll
        for (int r = 0; r < 4; ++r) part[(w * 64 + 16 * m + 4 * lq + r) * 16 + l15] = acc[m][r];
    __syncthreads();
    const unsigned long long* ssq = P.SSQ + (size_t)(2 * layer) * M;
#pragma unroll
    for (int i = 0; i < 2; ++i) { const int o = tid + NT * i, t = o >> 4; float s = 0.f;
#pragma unroll
        for (int ww = 0; ww < 8; ++ww) s += part[ww * 1024 + o];
        lrb[o] = s * ssq_rstd(ssq[row0 + t]); }
    __syncthreads();
    const int l31 = lane & 31, hi = lane >> 5, j = 32 * w + l31;
    bf16x8 bw;
    { float wv[8];
#pragma unroll
      for (int i = 0; i < 8; ++i) wv[i] = P.wglr[(size_t)(layer * 16 + 8 * hi + i) * 256 + j];
      u32x4 u; u[0] = cvtpk(wv[0], wv[1]); u[1] = cvtpk(wv[2], wv[3]); u[2] = cvtpk(wv[4], wv[5]); u[3] = cvtpk(wv[6], wv[7]); bw = __builtin_bit_cast(bf16x8, u); }
    const float bg = P.bgate[layer * 256 + j];
#pragma unroll
    for (int tb = 0; tb < 2; ++tb) {
        const f32x4 a0 = *(const LAS f32x4*)(lrb + (tb * 32 + l31) * 16 + 8 * hi), a1 = *(const LAS f32x4*)(lrb + (tb * 32 + l31) * 16 + 8 * hi + 4);
        const bf16x8 af = __builtin_bit_cast(bf16x8, pack8(a0, a1));
        f32x16 d;
#pragma unroll
        for (int r = 0; r < 16; ++r) d[r] = bg;
        d = MFMA32(af, bw, d);
#pragma unroll
        for (int r = 0; r < 16; ++r) { const float g = d[r];
            P.LA()[pofs(row0 + tb * 32 + crow(r, hi), 256) + j] = (bf16_t)(cvtpk((fminf(g, 0.f) - LOG2F(1.0f + EXP2F(-fabsf(g) * LOG2E)) * LN2) * 0.0625f, 0.f) & 0xffffu); } }
    __syncthreads();
}

template <bool STORE = true> DEV void att_unit(const Ptrs& P, int layer, lds_t lds, int b, int c, int hg) {
    int tid_ = threadIdx.x; OPAQUE_V(tid_); const int tid = tid_, lane = tid & 63, w = tid >> 6, hl = w >> 1, qb = w & 1, l31 = lane & 31, hi = lane >> 5;
    const int h = hg * 4 + hl; const size_t row0 = (size_t)b * SEQ;
    LAS float* bt = (LAS float*)(lds + ATT_BT);
    for (int i = tid; i < 4 * NREL; i += NT) { const int hh = i / NREL, j = i % NREL; bt[hh * 260 + j] = P.relb[(size_t)(layer * 8 + hg * 4 + hh) * NREL + j] * LOG2E; }
    const size_t qrow = row0 + c * 64 + qb * 32 + l31;
    bf16x8 qf[4];
#pragma unroll
    for (int ks = 0; ks < 4; ++ks) qf[ks] = *(const bf16x8*)(P.QA() + pofs(qrow, 512) + h * 64 + ks * 16 + hi * 8);
    f32x16 oT[2];
#pragma unroll
    for (int r = 0; r < 16; ++r) { oT[0][r] = 0.f; oT[1][r] = 0.f; }
    float mrun = -1e30f, lrun = 0.f;
    const int t0 = (c >= 8) ? 0 : 8 - c;
    u32x4 kreg[4], vreg[4];
    const unsigned gofs = (unsigned)((tid >> 5) * 512 + hg * 256 + (tid & 31) * 8), lkofs = (unsigned)((tid >> 5) * ATT_KSTR + (tid & 31) * 16), lvofs = (unsigned)((tid >> 5) * ATT_VSTR + (tid & 31) * 16);
#define ATT_LOAD(t) do { const bf16_t* kb_ = P.KA() + pofs(row0 + (size_t)(c - 8 + (t)) * 64, 512); const bf16_t* vb_ = kb_ + (O_VA - O_KA); _Pragma("unroll") for (int i = 0; i < 4; ++i) { \
        kreg[i] = *(const u32x4*)(kb_ + gofs + i * 16 * 512); vreg[i] = *(const u32x4*)(vb_ + gofs + i * 16 * 512); } } while (0)
#define ATT_STORE(buf) do { const lds_t kd_ = lds + ATT_K0 + (buf) * ATT_KT + lkofs, vd_ = lds + ATT_V0 + (buf) * ATT_VT + lvofs; _Pragma("unroll") for (int i = 0; i < 4; ++i) { \
        *(LAS u32x4*)(kd_ + i * 16 * ATT_KSTR) = kreg[i]; *(LAS u32x4*)(vd_ + i * 16 * ATT_VSTR) = vreg[i]; } } while (0)
    ATT_LOAD(t0); ATT_STORE(0);
    __syncthreads();
    for (int t = t0; t <= 8; ++t) {
        const int buf = (t - t0) & 1;
        if (t < 8) ATT_LOAD(t + 1);
        const lds_t Kb = lds + ATT_K0 + buf * ATT_KT + hl * 128, Vb = lds + ATT_V0 + buf * ATT_VT + hl * 128;
        f32x16 s[2];
#pragma unroll
        for (int kb2 = 0; kb2 < 2; ++kb2) { f32x16 acc;
#pragma unroll
            for (int r = 0; r < 16; ++r) acc[r] = 0.f;
#pragma unroll
            for (int ks = 0; ks < 4; ++ks) { const bf16x8 a = *(const LAS bf16x8*)(Kb + (kb2 * 32 + l31) * ATT_KSTR + (ks * 16 + hi * 8) * 2); acc = MFMA32(a, qf[ks], acc); }
            s[kb2] = acc; }
        const LAS float* bth = bt + hl * 260;
        float c0 = 0.f;
        if (t <= 5) c0 = bth[256];
        else { const int base = 512 + qb * 32 + l31 - t * 64;
#pragma unroll
            for (int kb2 = 0; kb2 < 2; ++kb2)
#pragma unroll
                for (int r = 0; r < 16; ++r) { int d = base - (kb2 * 32 + crow(r, hi)); d = d > 128 ? 128 : d; const float bv = bth[d + 128]; ADD_INPLACE(s[kb2][r], bv); } }
        float mx = s[0][0];
#pragma unroll
        for (int r = 0; r < 16; ++r) { mx = fmaxf(mx, s[0][r]); mx = fmaxf(mx, s[1][r]); }
        mx = fmaxf(mx, SHFL_XOR(mx, 32)) + c0;
        const bool up = mx > mrun + 8.0f;
        if (WAVE_ANY(up)) { const float mnew = up ? mx : mrun, alpha = EXP2F(mrun - mnew); mrun = mnew; lrun *= alpha;
#pragma unroll
            for (int r = 0; r < 16; ++r) { oT[0][r] *= alpha; oT[1][r] *= alpha; } }
        const f32x2 sh = {c0 - mrun, c0 - mrun}; f32x2 ps = {0.f, 0.f};
#pragma unroll
        for (int kb2 = 0; kb2 < 2; ++kb2)
#pragma unroll
            for (int r = 0; r < 16; r += 2) { const f32x2 v = (f32x2){s[kb2][r], s[kb2][r + 1]} + sh; const f32x2 e = {EXP2F(v[0]), EXP2F(v[1])}; s[kb2][r] = e[0]; s[kb2][r + 1] = e[1]; ps += e; }
        lrun += ps[0] + ps[1];
        bf16x8 pf[2][2];
#pragma unroll
        for (int kb2 = 0; kb2 < 2; ++kb2)
#pragma unroll
            for (int s2 = 0; s2 < 2; ++s2) { u32x4 u;
#pragma unroll
                for (int j = 0; j < 4; ++j) u[j] = cvtpk(s[kb2][8 * s2 + 2 * j], s[kb2][8 * s2 + 2 * j + 1]);
                pf[kb2][s2] = __builtin_bit_cast(bf16x8, u); }
#pragma unroll
        for (int db = 0; db < 2; ++db)
#pragma unroll
            for (int kb2 = 0; kb2 < 2; ++kb2)
#pragma unroll
                for (int s2 = 0; s2 < 2; ++s2) { const int keyb = kb2 * 32 + s2 * 16 + 4 * hi + ((lane & 15) >> 2), colb = db * 32 + 16 * ((lane >> 4) & 1) + 4 * (lane & 3);
                    const s16x4 lo = TR_READ(Vb + keyb * ATT_VSTR + colb * 2), h4 = TR_READ(Vb + (keyb + 8) * ATT_VSTR + colb * 2);
                    const bf16x8 a = {lo[0], lo[1], lo[2], lo[3], h4[0], h4[1], h4[2], h4[3]};
                    oT[db] = MFMA32(a, pf[kb2][s2], oT[db]); }
        if (t < 8) ATT_STORE(buf ^ 1);
        __syncthreads();
    }
#undef ATT_LOAD
#undef ATT_STORE
    const float inv = RCPF(lrun + SHFL_XOR(lrun, 32));
    bf16_t* yp = P.QA() + pofs(qrow, 512) + h * 64;
#pragma unroll
    for (int db = 0; db < 2; ++db)
#pragma unroll
        for (int g4 = 0; g4 < 4; ++g4) { u32x2 o; o[0] = cvtpk(oT[db][4 * g4] * inv, oT[db][4 * g4 + 1] * inv); o[1] = cvtpk(oT[db][4 * g4 + 2] * inv, oT[db][4 * g4 + 3] * inv);
            if (STORE) *(u32x2*)(yp + db * 32 + 8 * g4 + 4 * hi) = o; }
}

constexpr int NSC = NCH / 4, NUNIT = BATCH * 4 * NSC;
constexpr int GA_SET = 64 * G1_QSTR * 2 + 64 * G1_ESTR + 64 * G1_VSTR;
constexpr int GA_QT = 0, GA_KT = GA_QT + 64 * G1_QSTR, GA_KE = GA_KT + 64 * G1_QSTR, GA_V = GA_KE + 64 * G1_ESTR;
constexpr int GA_ST = 2 * GA_SET, GA_STSZ = 128 * G1_QSTR, GA_TOT = GA_ST + 2 * GA_STSZ, GA_DEC = GA_TOT + 2 * 8 * 64 * 4, GA_END = GA_DEC + 2 * 256;
template <bool STORE = true> DEV void gla_a_unit(const Ptrs& P, lds_t lds, int u) {
    int tid_ = threadIdx.x; OPAQUE_V(tid_); const int tid = tid_, lane = tid & 63, w = tid >> 6, l31 = lane & 31, hi = lane >> 5;
    const int sc = u % NSC, bh = u / NSC, h = bh & 3, b = bh >> 2;
    const int dvb = w >> 1, ib = w & 1;
    const int tt = lane & 7, db = lane >> 3, tk = 8 * w + tt;
    float dstart[8];
#pragma unroll
    for (int i = 0; i < 8; ++i) dstart[i] = 1.f;
    f32x16 st;
#pragma unroll
    for (int r = 0; r < 16; ++r) st[r] = 0.f;
    u32x4 la[4], qr[4], kr[4], vreg[4][2];
    bf16_t* const pan = P.proj + (size_t)(b * (SEQ / 256) + sc) * PBE;
    const unsigned eofs = (unsigned)(tk * 256 + h * 64 + 8 * db), vofs = (unsigned)((tid >> 4) * 512 + h * 128 + (tid & 15) * 8);
#pragma unroll
    for (int j = 0; j < 4; ++j) {
        la[j] = *(const u32x4*)(pan + O_LA + eofs + j * 64 * 256);
        qr[j] = *(const u32x4*)(pan + O_QB + eofs + j * 64 * 256); kr[j] = *(const u32x4*)(pan + O_KB + eofs + j * 64 * 256);
#pragma unroll
        for (int i = 0; i < 2; ++i) vreg[j][i] = *(const u32x4*)(pan + O_VB + vofs + (j * 64 + i * 32) * 512); }
    float mk[16];
#pragma unroll
    for (int r = 0; r < 16; ++r) mk[r] = crow(r, hi) > l31 ? 0.f : 1.f;
    const int colbV = dvb * 32 + 16 * ((lane >> 4) & 1) + 4 * (lane & 3), colbK = ib * 32 + 16 * ((lane >> 4) & 1) + 4 * (lane & 3);
    const float m1 = tt >= 1 ? 1.f : 0.f, m2 = tt >= 2 ? 1.f : 0.f, m4 = tt >= 4 ? 1.f : 0.f;
    const int grp = lane & ~7;
#pragma unroll
    for (int j = 0; j < 4; ++j) {
        const size_t row0 = ((size_t)b * NCH + 4 * sc + j) * 64; const size_t item = ((size_t)b * NCH + 4 * sc + j) * 4 + h;
        const lds_t S = lds + (j & 1) * GA_SET;
        LAS float* tot = (LAS float*)(lds + GA_TOT + (j & 1) * 2048); LAS float* dec = (LAS float*)(lds + GA_DEC + (j & 1) * 256);
        float lc[8];
        { f32x4 l0, l1; unpack8(la[j], l0, l1);
#pragma unroll
          for (int i = 0; i < 4; ++i) { lc[i] = l0[i]; lc[4 + i] = l1[i]; } }
#pragma unroll
        for (int i = 0; i < 8; ++i) lc[i] = fmaf(DPP_SHR_F(lc[i], 1), m1, lc[i]);
#pragma unroll
        for (int i = 0; i < 8; ++i) lc[i] = fmaf(DPP_SHR_F(lc[i], 2), m2, lc[i]);
#pragma unroll
        for (int i = 0; i < 8; ++i) lc[i] = fmaf(DPP_SHR_F(lc[i], 4), m4, lc[i]);
        if (tt == 7) { *(LAS f32x4*)(tot + w * 64 + 8 * db) = (f32x4){lc[0], lc[1], lc[2], lc[3]}; *(LAS f32x4*)(tot + w * 64 + 8 * db + 4) = (f32x4){lc[4], lc[5], lc[6], lc[7]}; }
#pragma unroll
        for (int i = 0; i < 2; ++i) { const int pc = tid + NT * i, row = pc >> 4, ch = pc & 15; *(LAS u32x4*)(S + GA_V + row * G1_VSTR + ch * 16) = vreg[j][i]; }
        __syncthreads();
        float off1 = 0.f, tot1 = 0.f;
#pragma unroll
        for (int s = 0; s < 8; ++s) { const float x = tot[s * 64 + 8 * db + tt]; tot1 += x; off1 += (s < w) ? x : 0.f; }
        const float dtot1 = EXP2F(tot1 * LOG2E);
        f32x4 q0, q1, k0, k1; unpack8(qr[j], q0, q1); unpack8(kr[j], k0, k1);
        float qt[8], kt[8], ke[8], qd[8];
#pragma unroll
        for (int i = 0; i < 8; ++i) { const float dti = bperm_f(grp + i, dtot1), bcur = bperm_f(grp + i, off1) + lc[i], qv = i < 4 ? q0[i & 3] : q1[i & 3], kv = i < 4 ? k0[i & 3] : k1[i & 3];
            qt[i] = qv * EXP2F(bcur * LOG2E); kt[i] = kv * EXP2F(-bcur * LOG2E); ke[i] = kt[i] * dti; qd[i] = qt[i] * dstart[i]; dstart[i] *= dti; }
        *(LAS u32x4*)(S + GA_QT + tk * G1_QSTR + db * 16) = pack8((f32x4){qt[0], qt[1], qt[2], qt[3]}, (f32x4){qt[4], qt[5], qt[6], qt[7]});
        *(LAS u32x4*)(S + GA_KT + tk * G1_QSTR + db * 16) = pack8((f32x4){kt[0], kt[1], kt[2], kt[3]}, (f32x4){kt[4], kt[5], kt[6], kt[7]});
        *(LAS u32x4*)(S + GA_KE + tk * G1_ESTR + db * 16) = pack8((f32x4){ke[0], ke[1], ke[2], ke[3]}, (f32x4){ke[4], ke[5], ke[6], ke[7]});
        if (STORE) *(u32x4*)(pan + O_QB + eofs + j * 64 * 256) = pack8((f32x4){qd[0], qd[1], qd[2], qd[3]}, (f32x4){qd[4], qd[5], qd[6], qd[7]});
        if (w == 0) dec[8 * db + tt] = dtot1;
        __syncthreads();
        f32x16 oi;
#pragma unroll
        for (int r = 0; r < 16; ++r) oi[r] = 0.f;
        for (int jb = 0; jb <= ib; ++jb) {
            f32x16 att;
#pragma unroll
            for (int r = 0; r < 16; ++r) att[r] = 0.f;
#pragma unroll
            for (int ks = 0; ks < 4; ++ks) { const bf16x8 a = *(const LAS bf16x8*)(S + GA_KT + (jb * 32 + l31) * G1_QSTR + (ks * 16 + hi * 8) * 2);
                const bf16x8 bq = *(const LAS bf16x8*)(S + GA_QT + (ib * 32 + l31) * G1_QSTR + (ks * 16 + hi * 8) * 2);
                att = MFMA32(a, bq, att); }
            if (jb == ib) {
#pragma unroll
                for (int r = 0; r < 16; ++r) att[r] *= mk[r]; }
#pragma unroll
            for (int s2 = 0; s2 < 2; ++s2) { u32x4 uu;
#pragma unroll
                for (int e = 0; e < 4; ++e) uu[e] = cvtpk(att[8 * s2 + 2 * e], att[8 * s2 + 2 * e + 1]);
                const bf16x8 pf = __builtin_bit_cast(bf16x8, uu);
                const int keyb = jb * 32 + s2 * 16 + 4 * hi + ((lane & 15) >> 2);
                const s16x4 lo = TR_READ(S + GA_V + keyb * G1_VSTR + colbV * 2), h4 = TR_READ(S + GA_V + (keyb + 8) * G1_VSTR + colbV * 2);
                const bf16x8 a = {lo[0], lo[1], lo[2], lo[3], h4[0], h4[1], h4[2], h4[3]};
                oi = MFMA32(a, pf, oi); }
        }
        if (j > 0) {
            const lds_t STp = lds + GA_ST + ((j - 1) & 1) * GA_STSZ;
#pragma unroll
            for (int ks = 0; ks < 4; ++ks) { const bf16x8 a = *(const LAS bf16x8*)(STp + (dvb * 32 + l31) * G1_QSTR + (ks * 16 + hi * 8) * 2);
                const bf16x8 bq = *(const LAS bf16x8*)(S + GA_QT + (ib * 32 + l31) * G1_QSTR + (ks * 16 + hi * 8) * 2);
                oi = MFMA32(a, bq, oi); } }
        { bf16_t* op = (bf16_t*)P.OI + (item * 8 + w) * 16 * 64 + lane * 8;
#pragma unroll
          for (int g8 = 0; g8 < 2; ++g8) *(u32x4*)(op + g8 * 512) = pack8((f32x4){oi[8 * g8], oi[8 * g8 + 1], oi[8 * g8 + 2], oi[8 * g8 + 3]}, (f32x4){oi[8 * g8 + 4], oi[8 * g8 + 5], oi[8 * g8 + 6], oi[8 * g8 + 7]}); }
        f32x16 ds;
#pragma unroll
        for (int r = 0; r < 16; ++r) ds[r] = 0.f;
#pragma unroll
        for (int s = 0; s < 4; ++s) { const int tb = s * 16 + 4 * hi + ((lane & 15) >> 2);
            const s16x4 alo = TR_READ(S + GA_V + tb * G1_VSTR + colbV * 2), ahi = TR_READ(S + GA_V + (tb + 8) * G1_VSTR + colbV * 2);
            const s16x4 blo = TR_READ(S + GA_KE + tb * G1_ESTR + colbK * 2), bhi = TR_READ(S + GA_KE + (tb + 8) * G1_ESTR + colbK * 2);
            const bf16x8 a = {alo[0], alo[1], alo[2], alo[3], ahi[0], ahi[1], ahi[2], ahi[3]}, bb = {blo[0], blo[1], blo[2], blo[3], bhi[0], bhi[1], bhi[2], bhi[3]};
            ds = MFMA32(a, bb, ds); }
        const float dl = dec[ib * 32 + l31];
#pragma unroll
        for (int r = 0; r < 16; ++r) st[r] = fmaf(dl, st[r], ds[r]);
        {
            const lds_t STn = lds + GA_ST + (j & 1) * GA_STSZ;
#pragma unroll
            for (int r = 0; r < 16; r += 2) { const unsigned pk = cvtpk(st[r], st[r + 1]);
                *(LAS bf16_t*)(STn + (dvb * 32 + crow(r, hi)) * G1_QSTR + (ib * 32 + l31) * 2) = (bf16_t)(pk & 0xffffu); *(LAS bf16_t*)(STn + (dvb * 32 + crow(r, hi) + 1) * G1_QSTR + (ib * 32 + l31) * 2) = (bf16_t)(pk >> 16); } }
    }
    __syncthreads();
    { const lds_t ST3 = lds + GA_ST + GA_STSZ;
#pragma unroll
      for (int i = 0; i < 2; ++i) { const int pc = tid + NT * i, row = pc >> 3, ch = pc & 7; *(u32x4*)(P.DSS + (size_t)u * 8192 + row * 64 + ch * 8) = *(const LAS u32x4*)(ST3 + row * G1_QSTR + ch * 16); } }
    if (tk == 0) { float* dtp = P.DT + (size_t)u * 64 + 8 * db; *(f32x4*)dtp = (f32x4){dstart[0], dstart[1], dstart[2], dstart[3]}; *(f32x4*)(dtp + 4) = (f32x4){dstart[4], dstart[5], dstart[6], dstart[7]}; }
    __syncthreads();
}

constexpr int GB_YSTR = 272;
constexpr int GB_ST = 0, GB_RED = 128 * G1_QSTR, GB_DT = GB_RED + 2048, GB_Q = GB_DT + 8 * 64 * 4, GB_QSZ = 64 * G1_QSTR, GB_TSZ = 64 * GB_YSTR, GB_RB = GB_Q + 2 * GB_QSZ, GB_Y = GB_RB + 2 * GB_TSZ, GB_END = GB_Y + 2 * GB_TSZ;
DEV void gla_b_unit(const Ptrs& P, int layer, lds_t lds, int u) {
    int tid_ = threadIdx.x; OPAQUE_V(tid_); const int tid = tid_, lane = tid & 63, w = tid >> 6, l31 = lane & 31, hi = lane >> 5;
    const int sc = u % NSC, bh = u / NSC, h = bh & 3, b = bh >> 2, u0 = u - sc;
    const int dvb = w >> 1, ib = w & 1;
    u32x4 on[2], qn, rbn[2];
    bf16_t* const pan = P.proj + (size_t)(b * (SEQ / 256) + sc) * PBE;
    const unsigned vofs = (unsigned)((tid >> 4) * 512 + h * 128 + (tid & 15) * 8), qofs = (unsigned)((tid >> 3) * 256 + h * 64 + (tid & 7) * 8);
#define GB_LOAD(j) do { const size_t item_ = ((size_t)b * NCH + 4 * sc + (j)) * 4 + h; const bf16_t* op = (const bf16_t*)P.OI + (item_ * 8 + w) * 16 * 64 + lane * 8; \
        _Pragma("unroll") for (int g8 = 0; g8 < 2; ++g8) on[g8] = *(const u32x4*)(op + g8 * 512); \
        _Pragma("unroll") for (int i = 0; i < 2; ++i) rbn[i] = *(const u32x4*)(pan + O_RB + vofs + ((j) * 64 + i * 32) * 512); \
        if (sc > 0) qn = *(const u32x4*)(pan + O_QB + qofs + (j) * 64 * 256); } while (0)
    GB_LOAD(0);
    f32x4 gg[4];
#pragma unroll
    for (int g4 = 0; g4 < 4; ++g4) gg[g4] = *(const f32x4*)(P.gng + layer * 512 + h * 128 + dvb * 32 + 8 * g4 + 4 * hi);
    if (sc > 0) {
        LAS float* dts = (LAS float*)(lds + GB_DT);
        bf16x8 vv[2][NSC - 1];
#pragma unroll
        for (int pp = 0; pp < 2; ++pp)
#pragma unroll
            for (int s = 0; s < NSC - 1; ++s) { const int ss = s < sc ? s : sc - 1; vv[pp][s] = *(const bf16x8*)(P.DSS + (size_t)(u0 + ss) * 8192 + (pp * NT + tid) * 8); }
        if (tid < (NSC - 1) * 64) { const int s = tid >> 6, ss = s < sc ? s : sc - 1; dts[tid] = P.DT[(size_t)(u0 + ss) * 64 + (tid & 63)]; }
        __syncthreads();
#pragma unroll
        for (int pp = 0; pp < 2; ++pp) { const int e8 = (pp * NT + tid) * 8, dkk = e8 & 63; f32x4 sa = {0.f, 0.f, 0.f, 0.f}, sb = {0.f, 0.f, 0.f, 0.f};
#pragma unroll
            for (int s = 0; s < NSC - 1; ++s) if (s < sc) { const f32x4 da = *(const LAS f32x4*)(dts + s * 64 + dkk), db = *(const LAS f32x4*)(dts + s * 64 + dkk + 4); f32x4 va, vb; unpack8(__builtin_bit_cast(u32x4, vv[pp][s]), va, vb);
                sa = da * sa + va; sb = db * sb + vb; }
            *(LAS u32x4*)(lds + GB_ST + (e8 >> 6) * G1_QSTR + dkk * 2) = pack8(sa, sb); }
    }
    LAS float* red = (LAS float*)(lds + GB_RED);
#define GB_YSTORE(jj) do { const lds_t ys_ = lds + GB_Y + ((jj) & 1) * GB_TSZ; _Pragma("unroll") for (int i = 0; i < 2; ++i) { const int pc = tid + NT * i; \
        *(u32x4*)(pan + O_VB + vofs + ((jj) * 64 + i * 32) * 512) = *(const LAS u32x4*)(ys_ + (pc >> 4) * GB_YSTR + (pc & 15) * 16); } } while (0)
#pragma unroll 1
    for (int j = 0; j < 4; ++j) {
        const lds_t Qt = lds + GB_Q + (j & 1) * GB_QSZ, Rt = lds + GB_RB + (j & 1) * GB_TSZ, Yt = lds + GB_Y + (j & 1) * GB_TSZ;
        f32x16 o;
#pragma unroll
        for (int g8 = 0; g8 < 2; ++g8) { f32x4 a, c; unpack8(on[g8], a, c);
#pragma unroll
            for (int e = 0; e < 4; ++e) { o[8 * g8 + e] = a[e]; o[8 * g8 + 4 + e] = c[e]; } }
#pragma unroll
        for (int i = 0; i < 2; ++i) { const int pc = tid + NT * i; *(LAS u32x4*)(Rt + (pc >> 4) * GB_YSTR + (pc & 15) * 16) = rbn[i]; }
        if (sc > 0) *(LAS u32x4*)(Qt + (tid >> 3) * G1_QSTR + (tid & 7) * 16) = qn;
        __syncthreads();
        if (j > 0) GB_YSTORE(j - 1);
        if (j < 3) GB_LOAD(j + 1);
        if (sc > 0) {
#pragma unroll
            for (int ks = 0; ks < 4; ++ks) { const bf16x8 a = *(const LAS bf16x8*)(lds + GB_ST + (dvb * 32 + l31) * G1_QSTR + (ks * 16 + hi * 8) * 2);
                const bf16x8 bq = *(const LAS bf16x8*)(Qt + (ib * 32 + l31) * G1_QSTR + (ks * 16 + hi * 8) * 2);
                o = MFMA32(a, bq, o); } }
        float ss = 0.f;
#pragma unroll
        for (int r = 0; r < 16; ++r) ss += o[r] * o[r];
        ss += SHFL_XOR(ss, 32);
        if (hi == 0) red[(j & 1) * 256 + w * 32 + l31] = ss;
        __syncthreads();
        const LAS float* rr = red + (j & 1) * 256;
        const float tot = (rr[ib * 32 + l31] + rr[(2 + ib) * 32 + l31]) + (rr[(4 + ib) * 32 + l31] + rr[(6 + ib) * 32 + l31]);
        const float rs = RSQF(tot * (1.0f / 128.f) + EPS);
#pragma unroll
        for (int g4 = 0; g4 < 4; ++g4) { const int dv0 = dvb * 32 + 8 * g4 + 4 * hi; const f32x4 g = gg[g4]; const int lo = (ib * 32 + l31) * GB_YSTR + dv0 * 2;
            const u32x2 rb = *(const LAS u32x2*)(Rt + lo);
            u32x2 ov; ov[0] = cvtpk(o[4 * g4] * rs * g[0] * bflo(rb[0]), o[4 * g4 + 1] * rs * g[1] * bfhi(rb[0])); ov[1] = cvtpk(o[4 * g4 + 2] * rs * g[2] * bflo(rb[1]), o[4 * g4 + 3] * rs * g[3] * bfhi(rb[1]));
            *(LAS u32x2*)(Yt + lo) = ov; }
    }
    __syncthreads();
    GB_YSTORE(3);
#undef GB_YSTORE
#undef GB_LOAD
    __syncthreads();
}
namespace pg8 {
#define PG8_LAS __attribute__((address_space(3)))
typedef unsigned short bf16_t;
typedef short bf16x8 __attribute__((ext_vector_type(8)));
typedef float f32x4 __attribute__((ext_vector_type(4)));
typedef unsigned u32x4 __attribute__((ext_vector_type(4)));
constexpr int BM = 256, BK = 64, HALF = 128, HTB = HALF * BK * 2  , STAGE_BYTES = 8 * HTB, NXCD = 8, WGM = 8;

__host__ __device__ __forceinline__ int lds_byte(int r, int c) { const int st = (r >> 4) * 2 + (c >> 5), rr = r & 15, cc = c & 31, ob = rr * 64 + cc * 2; return st * 1024 + (ob ^ (((ob >> 9) & 1) << 5)); }
__host__ __device__ __forceinline__ void stage_rc(int b, int& R, int& C) { const int st = b / 1024, sb = b % 1024, swz = sb ^ (((sb >> 9) & 1) << 5); R = (st >> 1) * 16 + swz / 64; C = (st & 1) * 32 + (swz % 64) / 2; }
__host__ __device__ __forceinline__ int perm32(int rho) { const int n = rho >> 4, i = rho & 15; return 8 * (i >> 2) + 4 * n + (i & 3); }

struct Unit { int pm, pn; };
struct Gemm { const bf16_t* A; const bf16_t* Bt; int M, N, K, lda, ldb; size_t a_tile_bytes; int amod; size_t ahi_bytes; };

struct StaticOrder {
    int nM, nN, nwg, G, c;
    __host__ __device__ void init(int M, int N, int G_, int c_) { nM = M / BM; nN = N / BM; nwg = nM * nN; G = G_; c = c_; }
    __host__ __device__ bool next(int i, Unit& u) const {
        const long L = (long)i * G + c; if (L >= nwg) return false;
        int wgid = (int)L; { const int q = nwg / NXCD, r = nwg % NXCD, xcd = wgid % NXCD, off = wgid / NXCD; wgid = (xcd < r ? xcd * (q + 1) : r * (q + 1) + (xcd - r) * q) + off; }
        const int nig = WGM * nN, gid = wgid / nig, fm = gid * WGM, gsz = (nM - fm) < WGM ? (nM - fm) : WGM;
        u.pm = fm + ((wgid % nig) % gsz); u.pn = (wgid % nig) / gsz; return true;
    }
    __device__ __forceinline__ void a_ready(const Unit&) const {}
    __device__ __forceinline__ void done(const Unit&) const {}
};

template <class Epi, class Sched, bool ALIGN_EPI = false, bool SP2 = false>
__device__ __forceinline__ void gemm_phase(PG8_LAS unsigned char* lds, const Gemm g, const Sched& S, const Epi& E) {
    int tid_ = threadIdx.x; asm volatile("" : "+v"(tid_));
    const int tid = tid_, wid = __builtin_amdgcn_readfirstlane(tid >> 6), lane = tid & 63, wr = wid >> 2, wc = wid & 3, fr = lane & 15, fq = lane >> 4;
    const int K = g.K, nt = K / BK;
    unsigned voffA[2], voffB[2];
#pragma unroll
    for (int i = 0; i < 2; ++i) { int R, C; stage_rc(tid * 16 + i * 8192, R, C); const int Rb = Epi::PERM ? ((R & ~31) + perm32(R & 31)) : R;
        voffA[i] = (unsigned)(R * g.lda + C) * 2u; voffB[i] = (unsigned)(Rb * g.ldb + C) * 2u; }
    const size_t kstep = (size_t)(BK * 2);
    const size_t hstepA = (size_t)HALF * g.lda * 2, hstepB = (size_t)HALF * g.ldb * 2;
    const size_t tstepB = 2 * hstepB;
#define PG8_AOF(pm_) ((const char*)g.A + (size_t)((pm_) % g.amod) * g.a_tile_bytes + (size_t)((pm_) / g.amod) * g.ahi_bytes)
    const unsigned ldsw = (unsigned)wid * 1024u;
    const int aoff = lds_byte(wr * 64 + fr, fq * 8), boff = lds_byte(wc * 32 + fr, fq * 8);
#define PG8_SA(b, h) (((b) * 2 + (h)) * HTB)
#define PG8_SB(b, h) ((4 + (b) * 2 + (h)) * HTB)
#define PG8_STAGE(bufoff, gbase, voff) do { _Pragma("unroll") for (int _i = 0; _i < 2; ++_i) \
        __builtin_amdgcn_global_load_lds((const unsigned*)((const char*)(gbase) + (voff)[_i]), (PG8_LAS unsigned*)(lds + (bufoff) + ldsw + _i * 8192), 16, 0, 0); } while (0)
#define PG8_LDA(dst, b, h) do { _Pragma("unroll") for (int m = 0; m < 4; ++m) _Pragma("unroll") for (int k = 0; k < 2; ++k) dst[m][k] = *(const PG8_LAS bf16x8*)(lds + PG8_SA(b, h) + aoff + m * 2048 + k * 1024); } while (0)
#define PG8_LDB(dst, b, h) do { _Pragma("unroll") for (int n = 0; n < 2; ++n) _Pragma("unroll") for (int k = 0; k < 2; ++k) dst[n][k] = *(const PG8_LAS bf16x8*)(lds + PG8_SB(b, h) + boff + n * 2048 + k * 1024); } while (0)
#define PG8_MMA(ai, bj, At, Bt) do { __builtin_amdgcn_s_setprio(1); _Pragma("unroll") for (int m = 0; m < 4; ++m) _Pragma("unroll") for (int n = 0; n < 2; ++n) _Pragma("unroll") for (int k = 0; k < 2; ++k) \
        acc[ai][bj][m][n] = __builtin_amdgcn_mfma_f32_16x16x32_bf16(Bt[n][k], At[m][k], acc[ai][bj][m][n], 0, 0, 0); __builtin_amdgcn_s_setprio(0); } while (0)
#define PG8_WAIT_V(n) asm volatile("s_waitcnt vmcnt(" #n ")" ::: "memory")
#define PG8_WAIT_L(n) asm volatile("s_waitcnt lgkmcnt(" #n ")" ::: "memory")
#define PG8_BAR __builtin_amdgcn_s_barrier()
#define PG8_SCHED __builtin_amdgcn_sched_barrier(0)
    Unit cur, nxt; int ui = 0;
    if (!S.next(0, cur)) return;
    f32x4 acc[2][2][4][2];
#pragma unroll
    for (int a = 0; a < 2; ++a)
#pragma unroll
        for (int b = 0; b < 2; ++b)
#pragma unroll
            for (int m = 0; m < 4; ++m)
#pragma unroll
                for (int n = 0; n < 2; ++n) acc[a][b][m][n] = (f32x4){0.f, 0.f, 0.f, 0.f};
    bf16x8 At[4][2], B0[2][2], B1[2][2];
    const char* cA = PG8_AOF(cur.pm); const char* cB = (const char*)g.Bt + (size_t)cur.pn * tstepB;
    S.a_ready(cur);
    if constexpr (SP2) {
        PG8_STAGE(PG8_SB(0, 0), cB, voffB); PG8_STAGE(PG8_SB(0, 1), cB + hstepB, voffB); PG8_STAGE(PG8_SA(0, 0), cA, voffA); PG8_STAGE(PG8_SA(0, 1), cA + hstepA, voffA);
        if (wr == 1) PG8_BAR;
        PG8_WAIT_V(2); PG8_BAR;
        PG8_STAGE(PG8_SB(1, 0), cB + kstep, voffB); PG8_STAGE(PG8_SA(1, 0), cA + kstep, voffA); PG8_STAGE(PG8_SB(1, 1), cB + hstepB + kstep, voffB);
        PG8_WAIT_V(6); PG8_BAR;
    } else {
        PG8_STAGE(PG8_SB(0, 0), cB, voffB); PG8_STAGE(PG8_SA(0, 0), cA, voffA); PG8_STAGE(PG8_SB(0, 1), cB + hstepB, voffB); PG8_STAGE(PG8_SA(0, 1), cA + hstepA, voffA);
        if (wr == 1) PG8_BAR;
        PG8_WAIT_V(4); PG8_BAR;
        PG8_STAGE(PG8_SB(1, 0), cB + kstep, voffB); PG8_STAGE(PG8_SA(1, 0), cA + kstep, voffA); PG8_STAGE(PG8_SB(1, 1), cB + hstepB + kstep, voffB);
        PG8_WAIT_V(6); PG8_BAR;
    }
    for (;;) {
        const bool has_next = S.next(ui + 1, nxt);
        const char* nA = has_next ? PG8_AOF(nxt.pm) : cA; const char* nB = has_next ? (const char*)g.Bt + (size_t)nxt.pn * tstepB : cB;
        for (int t = 0; t < nt; t += 2) {
            const bool last = (t == nt - 2);
            const char* a1 = cA + (size_t)(t + 1) * kstep;
            const char* a2 = last ? nA : cA + (size_t)(t + 2) * kstep; const char* b2 = last ? nB : cB + (size_t)(t + 2) * kstep;
            const char* a3 = a2 + kstep; const char* b3 = b2 + kstep;
            if (last && has_next) S.a_ready(nxt);
            if constexpr (SP2) {
            PG8_LDB(B0, 0, 0); PG8_LDB(B1, 0, 1); PG8_SCHED; PG8_LDA(At, 0, 0); PG8_STAGE(PG8_SA(1, 1), a1 + hstepA, voffA);
            PG8_WAIT_V(8); PG8_WAIT_L(0); PG8_BAR; PG8_MMA(0, 0, At, B0); PG8_MMA(0, 1, At, B1); PG8_BAR; PG8_SCHED;
            PG8_LDA(At, 0, 1); PG8_STAGE(PG8_SB(0, 0), b2, voffB); PG8_STAGE(PG8_SB(0, 1), b2 + hstepB, voffB); PG8_STAGE(PG8_SA(0, 0), a2, voffA);
            PG8_WAIT_V(8); PG8_WAIT_L(0); PG8_BAR; PG8_MMA(1, 0, At, B0); PG8_MMA(1, 1, At, B1); PG8_BAR; PG8_SCHED;
            PG8_LDB(B0, 1, 0); PG8_LDB(B1, 1, 1); PG8_SCHED; PG8_LDA(At, 1, 0); PG8_STAGE(PG8_SA(0, 1), a2 + hstepA, voffA);
            PG8_WAIT_V(8); PG8_WAIT_L(0); PG8_BAR; PG8_MMA(0, 0, At, B0); PG8_MMA(0, 1, At, B1); PG8_BAR; PG8_SCHED;
            PG8_LDA(At, 1, 1); PG8_STAGE(PG8_SB(1, 0), b3, voffB); PG8_STAGE(PG8_SB(1, 1), b3 + hstepB, voffB); PG8_STAGE(PG8_SA(1, 0), a3, voffA);
            PG8_WAIT_V(8); PG8_WAIT_L(0); PG8_BAR; PG8_MMA(1, 0, At, B0); PG8_MMA(1, 1, At, B1); PG8_BAR; PG8_SCHED;
            } else {
            PG8_LDB(B0, 0, 0); PG8_SCHED; PG8_LDA(At, 0, 0); PG8_STAGE(PG8_SA(1, 1), a1 + hstepA, voffA);
            PG8_WAIT_L(8); PG8_BAR; PG8_WAIT_L(0); PG8_MMA(0, 0, At, B0); PG8_BAR; PG8_SCHED;
            PG8_LDB(B1, 0, 1); PG8_STAGE(PG8_SB(0, 0), b2, voffB);
            PG8_BAR; PG8_WAIT_L(0); PG8_MMA(0, 1, At, B1); PG8_BAR;
            PG8_LDA(At, 0, 1); PG8_STAGE(PG8_SA(0, 0), a2, voffA);
            PG8_BAR; PG8_WAIT_L(0); PG8_MMA(1, 0, At, B0); PG8_BAR; PG8_SCHED;
            PG8_STAGE(PG8_SB(0, 1), b2 + hstepB, voffB);
            PG8_WAIT_V(6); PG8_BAR; PG8_MMA(1, 1, At, B1); PG8_BAR;
            PG8_LDB(B0, 1, 0); PG8_SCHED; PG8_LDA(At, 1, 0); PG8_STAGE(PG8_SA(0, 1), a2 + hstepA, voffA);
            PG8_WAIT_L(8); PG8_BAR; PG8_WAIT_L(0); PG8_MMA(0, 0, At, B0); PG8_BAR; PG8_SCHED;
            PG8_LDB(B1, 1, 1); PG8_STAGE(PG8_SB(1, 0), b3, voffB);
            PG8_BAR; PG8_WAIT_L(0); PG8_MMA(0, 1, At, B1); PG8_BAR;
            PG8_LDA(At, 1, 1); PG8_STAGE(PG8_SA(1, 0), a3, voffA);
            PG8_BAR; PG8_WAIT_L(0); PG8_MMA(1, 0, At, B0); PG8_BAR; PG8_SCHED;
            PG8_STAGE(PG8_SB(1, 1), b3 + hstepB, voffB);
            PG8_WAIT_V(6); PG8_BAR; PG8_MMA(1, 1, At, B1); PG8_BAR;
            }
        }
        if constexpr (ALIGN_EPI) { if (wr == 0) PG8_BAR; }
        if constexpr (!Epi::AFTER_DRAIN) { E(acc, cur, wr, wc, fr, fq); S.done(cur); }
        if (!has_next) break;
#pragma unroll
        for (int a = 0; a < 2; ++a)
#pragma unroll
            for (int b = 0; b < 2; ++b)
#pragma unroll
                for (int m = 0; m < 4; ++m)
#pragma unroll
                    for (int n = 0; n < 2; ++n) acc[a][b][m][n] = (f32x4){0.f, 0.f, 0.f, 0.f};
        cur = nxt; cA = nA; cB = nB; ++ui;
        if constexpr (ALIGN_EPI) { if (wr == 1) PG8_BAR; }
    }
    PG8_WAIT_V(0);
    if constexpr (!ALIGN_EPI) { if (wr == 0) PG8_BAR; }
    PG8_BAR;
    if constexpr (Epi::AFTER_DRAIN) { E.fused(acc, cur, wr, wc, fr, fq, lds, wid, lane); S.done(cur); }
#undef PG8_AOF
#undef PG8_SA
#undef PG8_SB
#undef PG8_STAGE
#undef PG8_LDA
#undef PG8_LDB
#undef PG8_MMA
#undef PG8_WAIT_V
#undef PG8_WAIT_L
#undef PG8_BAR
#undef PG8_SCHED
}
}
#ifdef EMU
namespace pg8 { struct Unit { int pm, pn; }; constexpr int BM = 256, HALF = 128; }
#endif
typedef f32x4 acc_t[2][2][4][2];

struct EpiIn {
    static constexpr bool PERM = true, AFTER_DRAIN = false;
    Ptrs P; const unsigned long long* ssq; const LAS float* rs_lds; int pm_lds;
    DEV void operator()(const acc_t& acc, const pg8::Unit& u, int wr, int wc, int fr_, int fq_) const {
        int fr = fr_, fq = fq_; OPAQUE_V(fr); OPAQUE_V(fq);
        const int pn = u.pn; bf16_t* base; int ld, c0, act = 0;
        if (pn < 2) { base = P.QA(); ld = 512; c0 = pn * 256; } else if (pn < 4) { base = P.KA(); ld = 512; c0 = (pn - 2) * 256; } else if (pn < 6) { base = P.VA(); ld = 512; c0 = (pn - 4) * 256; }
        else if (pn == 6) { base = P.QB(); ld = 256; c0 = 0; } else if (pn == 7) { base = P.KB(); ld = 256; c0 = 0; } else if (pn < 10) { base = P.VB(); ld = 512; c0 = (pn - 8) * 256; }
        else if (pn < 12) { base = P.RB(); ld = 512; c0 = (pn - 10) * 256; act = 1; }
        else if (pn < 16) { base = P.GA(); ld = 1024; c0 = (pn - 12) * 256; act = 2; } else { base = P.GB(); ld = 1024; c0 = (pn - 16) * 256; act = 2; }
        base += (size_t)u.pm * PBE;
        const int rowb = wr * 64 + fr, colb = c0 + wc * 32 + 8 * fq;
        float rs[2][4];
        const float bad = (u.pm == pm_lds) ? 1.0f : __builtin_nanf("");
#pragma unroll
        for (int ai = 0; ai < 2; ++ai)
#pragma unroll
            for (int m = 0; m < 4; ++m) rs[ai][m] = rs_lds[wr * 64 + fr + ai * 128 + m * 16] * bad;
        if (act == 0) body<0>(acc, rs, base, ld, rowb, colb); else if (act == 1) body<1>(acc, rs, base, ld, rowb, colb); else body<2>(acc, rs, base, ld, rowb, colb);
    }
    template <int ACT> DEV static void body(const acc_t& acc, const float (&rs)[2][4], bf16_t* base, int ld, int rowb, int colb) {
        const int lane = (rowb & 15) + 16 * (((colb & 31)) >> 3), r2 = (rowb & ~15) + (lane >> 2), c2 = (colb & ~31) + 8 * (lane & 3);
#pragma unroll
        for (int ai = 0; ai < 2; ++ai)
#pragma unroll
            for (int m = 0; m < 4; ++m) { bf16_t* rowp = base + (size_t)(r2 + ai * 128 + m * 16) * ld + c2;
#pragma unroll
                for (int bj = 0; bj < 2; ++bj) { const float sc_ = (ACT == 2) ? rs[ai][m] * -LOG2E : rs[ai][m];
                    f32x4 v0 = acc[ai][bj][m][0] * sc_, v1 = acc[ai][bj][m][1] * sc_;
                    if (ACT == 1) {
#pragma unroll
                        for (int e = 0; e < 4; ++e) { v0[e] = v0[e] * sigmoidf_(v0[e]); v1[e] = v1[e] * sigmoidf_(v1[e]); } }
                    else if (ACT == 2) {
#pragma unroll
                        for (int e = 0; e < 4; ++e) { v0[e] = RCPF(1.0f + EXP2F(v0[e])); v1[e] = RCPF(1.0f + EXP2F(v1[e])); } }
                    ST16_WT(rowp + bj * 128, quad_rows(pack8(v0, v1), lane)); }
                SCHED_FENCE(); }
    }
};
struct EpiMerge {
    static constexpr bool PERM = true, AFTER_DRAIN = false;
    Ptrs P;
    DEV void operator()(const acc_t& acc, const pg8::Unit& u, int wr, int wc, int fr_, int fq_) const {
        int fr = fr_, fq = fq_; OPAQUE_V(fr); OPAQUE_V(fq);
        const int br = u.pm >= (M / 256) ? 1 : 0, pm = u.pm - br * (M / 256), pn = u.pn - br * 4;
        const bf16_t* gate = br ? P.GB() : P.GA();
        const int lane = fr + 16 * fq, rowb = wr * 64 + (lane >> 2), colb = pn * 256 + wc * 32 + 8 * (lane & 3);
        const size_t pb = (size_t)pm * PBE;
        if (br == 0) body<0>(acc, gate, P.T(), P.MERGED(), pb, rowb, colb, lane); else body<1>(acc, gate, P.T(), P.MERGED(), pb, rowb, colb, lane);
    }
    template <int BR> DEV static void body(const acc_t& acc, const bf16_t* gate, bf16_t* T, bf16_t* MG, size_t pb, int rowb, int colb, int lane) {
#pragma unroll
        for (int ai = 0; ai < 2; ++ai) {
            u32x4 gv[4][2], tv[4][2];
#pragma unroll
            for (int m = 0; m < 4; ++m) { const size_t off = pb + (size_t)(rowb + ai * 128 + m * 16) * 1024 + colb;
#pragma unroll
                for (int bj = 0; bj < 2; ++bj) { gv[m][bj] = *(const u32x4*)(gate + off + bj * 128); if (BR) tv[m][bj] = *(const u32x4*)(T + off + bj * 128); } }
#pragma unroll
            for (int m = 0; m < 4; ++m) { const size_t off = pb + (size_t)(rowb + ai * 128 + m * 16) * 1024 + colb;
#pragma unroll
                for (int bj = 0; bj < 2; ++bj) { f32x4 g0, g1; unpack8(gv[m][bj], g0, g1);
                    f32x4 v0 = quad_rows_f(acc[ai][bj][m][0], lane) * g0, v1 = quad_rows_f(acc[ai][bj][m][1], lane) * g1;
                    if (BR == 0) *(u32x4*)(T + off + bj * 128) = pack8(v0, v1);
                    else { f32x4 t0, t1; unpack8(tv[m][bj], t0, t1); ST16_WT(MG + off + bj * 128, pack8(v0 + t0, v1 + t1)); } } }
            SCHED_FENCE();
        }
    }
};
template <bool DRY = false> struct EpiResT {
    static constexpr bool PERM = true, AFTER_DRAIN = false;
    Ptrs P; unsigned long long* ssq_out;
    DEV void operator()(const acc_t& acc, const pg8::Unit& u, int wr, int wc, int fr_, int fq_) const {
        int fr = fr_, fq = fq_; OPAQUE_V(fr); OPAQUE_V(fq);
        const int lane = fr + 16 * fq, rowb = u.pm * 256 + wr * 64 + (lane >> 2), colb = u.pn * 256 + wc * 32 + 8 * (lane & 3);
#pragma unroll
        for (int ai = 0; ai < 2; ++ai) {
            u32x4 xv[4][2];
#pragma unroll
            for (int m = 0; m < 4; ++m)
#pragma unroll
                for (int bj = 0; bj < 2; ++bj) xv[m][bj] = *(const u32x4*)(P.XN + (size_t)(rowb + ai * 128 + m * 16) * DM + colb + bj * 128);
#pragma unroll
            for (int m = 0; m < 4; ++m) { const int row = rowb + ai * 128 + m * 16; const size_t off = (size_t)row * DM + colb; float s = 0.f;
#pragma unroll
                for (int bj = 0; bj < 2; ++bj) { bf16_t* xp = P.XN + off + bj * 128; f32x4 r0, r1; unpack8(xv[m][bj], r0, r1);
                    r0 += quad_rows_f(acc[ai][bj][m][0], lane); r1 += quad_rows_f(acc[ai][bj][m][1], lane); if (!DRY) ST16_WT(xp, pack8(r0, r1)); else if (r0[0] == 1.2345e30f) ST16_WT(xp, pack8(r0, r1));
                    s += ((r0[0] * r0[0] + r0[1] * r0[1]) + (r0[2] * r0[2] + r0[3] * r0[3])) + ((r1[0] * r1[0] + r1[1] * r1[1]) + (r1[2] * r1[2] + r1[3] * r1[3])); }
                s += SHFL_XOR(s, 1); s += SHFL_XOR(s, 2);
                if ((lane & 3) == 0 && (!DRY || s == 1.2345e30f)) ATOMIC_ADD_U64(ssq_out + row, (unsigned long long)(s * SSQ_SCALE)); }
        }
    }
};
typedef EpiResT<false> EpiRes;
struct EpiUp {
    static constexpr bool PERM = true, AFTER_DRAIN = false;
    Ptrs P; const unsigned long long* ssq; const LAS float* rs_lds; int pm_lds;
    DEV void operator()(const acc_t& acc, const pg8::Unit& u, int wr, int wc, int fr_, int fq_) const {
        int fr = fr_, fq = fq_; OPAQUE_V(fr); OPAQUE_V(fq);
        const int rowb = u.pm * 256 + wr * 64 + fr, colb = u.pn * 256 + wc * 32 + 8 * fq;
        float rs[2][4];
        const float bad = (u.pm == pm_lds) ? 1.0f : __builtin_nanf("");
#pragma unroll
        for (int ai = 0; ai < 2; ++ai)
#pragma unroll
            for (int m = 0; m < 4; ++m) rs[ai][m] = rs_lds[wr * 64 + fr + ai * 128 + m * 16] * bad;
        const int lane = fr + 16 * fq, r2 = wr * 64 + (lane >> 2), c2 = u.pn * 256 + wc * 32 + 8 * (lane & 3);
#pragma unroll
        for (int ai = 0; ai < 2; ++ai)
#pragma unroll
            for (int m = 0; m < 4; ++m) { bf16_t* rowp = P.HID() + (size_t)u.pm * PBE + (size_t)(r2 + ai * 128 + m * 16) * LDH + c2;
#pragma unroll
                for (int bj = 0; bj < 2; ++bj) { f32x4 v0 = acc[ai][bj][m][0] * rs[ai][m], v1 = acc[ai][bj][m][1] * rs[ai][m];
#pragma unroll
                    for (int e = 0; e < 4; ++e) { v0[e] = fmaxf(v0[e], 0.f); v0[e] *= v0[e]; v1[e] = fmaxf(v1[e], 0.f); v1[e] *= v1[e]; }
                    ST16_WT(rowp + bj * 128, quad_rows(pack8(v0, v1), lane)); } }
    }
};
#define XB_TMO      128
#define XB_XCNT(j)  (256  + 64 * (j))
#define XB_XSUB(j)  (1280 + 64 * (j))
#define XB_XGEN(j)  (2304 + 64 * (j))
#define XB_TOP      3328
#define XB_TOPGEN   3392
#define XCD_BAR_WORDS 3456
#define XB_SPIN_CAP (1u << 18)

__device__ __forceinline__ unsigned xb_ld(unsigned* p)              { return __hip_atomic_load(p, __ATOMIC_RELAXED, __HIP_MEMORY_SCOPE_AGENT); }
__device__ __forceinline__ unsigned xb_add(unsigned* p, unsigned v) { return __hip_atomic_fetch_add(p, v, __ATOMIC_RELAXED, __HIP_MEMORY_SCOPE_AGENT); }
__device__ __forceinline__ unsigned xb_xcc_id() { return (unsigned)__builtin_amdgcn_s_getreg((3 << 11) | 20) & 0xFu; }
#define XB_SPIN(cond, bar) do { unsigned _sp = 0; while (cond) { __builtin_amdgcn_s_sleep(1); \
    if ((++_sp & 255u) == 0u) { if (xb_ld(&(bar)[XB_TMO])) break; if (_sp > XB_SPIN_CAP) { atomicAdd(&(bar)[XB_TMO], 1u); break; } } } } while (0)

struct XcdBarrier {
    unsigned* bar; unsigned x;
    volatile LAS unsigned* st;
};

__device__ __forceinline__ XcdBarrier xcd_barrier_post(unsigned* bar, volatile LAS unsigned* st) {
    XcdBarrier b; b.bar = bar; b.x = xb_xcc_id(); b.st = st;
    if (threadIdx.x == 0) (void)xb_add(&bar[XB_XCNT(b.x)], 1u);
    return b;
}
__device__ __forceinline__ void xcd_barrier_complete(unsigned* bar, unsigned x, unsigned& nloc, unsigned& nx) {
    const unsigned G = gridDim.x * gridDim.y * gridDim.z;
    unsigned sum, cnt, mine, sp = 0u;
    for (;;) {
        sum = 0u; cnt = 0u; mine = 0u;
#pragma unroll
        for (unsigned j = 0; j < 16; ++j) { const unsigned c = xb_ld(&bar[XB_XCNT(j)]); sum += c; cnt += (c > 0u) ? 1u : 0u; mine = (j == x) ? c : mine; }
        if (sum == G) break;
        __builtin_amdgcn_s_sleep(1);
        if ((++sp & 255u) == 0u) { if (xb_ld(&bar[XB_TMO])) break; if (sp > XB_SPIN_CAP) { atomicAdd(&bar[XB_TMO], 1u); break; } }
    }
    nloc = mine > 0u ? mine : 1u; nx = cnt > 0u ? cnt : 1u;
}

__device__ __forceinline__ void xcd_barrier(const XcdBarrier& b) {
    asm volatile("s_waitcnt vmcnt(0)" ::: "memory");
    __syncthreads();
    if (threadIdx.x == 0) {
        unsigned* bar = b.bar;
        __builtin_amdgcn_s_waitcnt(0);
        unsigned nloc = b.st[0], nx = b.st[1];
        if (nloc == 0u) { xcd_barrier_complete(bar, b.x, nloc, nx); b.st[0] = nloc; b.st[1] = nx; }
        const unsigned old = xb_add(&bar[XB_XSUB(b.x)], 1u);
        const unsigned gen = old / nloc;
        if (old + 1u == (gen + 1u) * nloc) {
            __builtin_amdgcn_fence(__ATOMIC_RELEASE, "agent");
            asm volatile("s_waitcnt vmcnt(0)" ::: "memory");
            const unsigned og = xb_add(&bar[XB_TOP], 1u);
            const unsigned tg = og / nx;
            if (og + 1u == (tg + 1u) * nx) xb_add(&bar[XB_TOPGEN], 1u);
            else XB_SPIN(xb_ld(&bar[XB_TOPGEN]) == tg, bar);
            __builtin_amdgcn_fence(__ATOMIC_ACQUIRE, "agent");
            xb_add(&bar[XB_XGEN(b.x)], 1u);
            asm volatile("s_waitcnt vmcnt(0)" ::: "memory");
        } else {
            XB_SPIN(xb_ld(&bar[XB_XGEN(b.x)]) == gen, bar);
            __builtin_amdgcn_fence(__ATOMIC_ACQUIRE, "agent");
            asm volatile("s_waitcnt vmcnt(0)" ::: "memory");
        }
    }
    __syncthreads();
}

__device__ __forceinline__ void xcd_barrier_arrive(const XcdBarrier& b) {
    asm volatile("s_waitcnt vmcnt(0)" ::: "memory");
    __syncthreads();
    if (threadIdx.x == 0) {
        unsigned* bar = b.bar;
        __builtin_amdgcn_s_waitcnt(0);
        unsigned nloc = b.st[0], nx = b.st[1];
        if (nloc == 0u) { xcd_barrier_complete(bar, b.x, nloc, nx); b.st[0] = nloc; b.st[1] = nx; }
        const unsigned old = xb_add(&bar[XB_XSUB(b.x)], 1u);
        const unsigned gen = old / nloc;
        if (old + 1u == (gen + 1u) * nloc) {
            __builtin_amdgcn_fence(__ATOMIC_RELEASE, "agent");
            asm volatile("s_waitcnt vmcnt(0)" ::: "memory");
            const unsigned og = xb_add(&bar[XB_TOP], 1u);
            const unsigned tg = og / nx;
            if (og + 1u == (tg + 1u) * nx) xb_add(&bar[XB_TOPGEN], 1u);
            b.st[2] = 1u; b.st[3] = tg;
        } else { b.st[2] = 0u; b.st[3] = gen; }
    }
}
__device__ __forceinline__ void xcd_barrier_wait(const XcdBarrier& b) {
    if (threadIdx.x == 0) {
        unsigned* bar = b.bar; const unsigned g = b.st[3];
        if (b.st[2]) { XB_SPIN(xb_ld(&bar[XB_TOPGEN]) == g, bar); __builtin_amdgcn_fence(__ATOMIC_ACQUIRE, "agent"); xb_add(&bar[XB_XGEN(b.x)], 1u); asm volatile("s_waitcnt vmcnt(0)" ::: "memory"); }
        else { XB_SPIN(xb_ld(&bar[XB_XGEN(b.x)]) == g, bar); __builtin_amdgcn_fence(__ATOMIC_ACQUIRE, "agent"); asm volatile("s_waitcnt vmcnt(0)" ::: "memory"); }
    }
    __syncthreads();
}

__device__ __forceinline__ void quad_barrier(unsigned* cnt, unsigned* tmo, unsigned same_xcd) {
    asm volatile("s_waitcnt vmcnt(0)" ::: "memory");
    __syncthreads();
    if (threadIdx.x == 0) {
        if (!same_xcd) { __builtin_amdgcn_fence(__ATOMIC_RELEASE, "agent"); asm volatile("s_waitcnt vmcnt(0)" ::: "memory"); }
        const unsigned old = xb_add(cnt, 1u);
        const unsigned target = (old / 4u + 1u) * 4u;
        XB_SPIN(xb_ld(cnt) < target, tmo);
        __builtin_amdgcn_fence(__ATOMIC_ACQUIRE, "agent");
        asm volatile("s_waitcnt vmcnt(0)" ::: "memory");
    }
    __syncthreads();
}

__device__ __forceinline__ void group_barrier(unsigned* cnt, unsigned* tmo, unsigned same, unsigned n) {
    asm volatile("s_waitcnt vmcnt(0)" ::: "memory");
    __syncthreads();
    if (threadIdx.x == 0) {
        if (!same) { __builtin_amdgcn_fence(__ATOMIC_RELEASE, "agent"); asm volatile("s_waitcnt vmcnt(0)" ::: "memory"); }
        const unsigned old = xb_add(cnt, 1u);
        const unsigned target = (old / n + 1u) * n;
        XB_SPIN(xb_ld(cnt) < target, tmo);
        __builtin_amdgcn_fence(__ATOMIC_ACQUIRE, "agent");
        asm volatile("s_waitcnt vmcnt(0)" ::: "memory");
    }
    __syncthreads();
}
__device__ __forceinline__ void group_arrive(unsigned* cnt, unsigned same, unsigned n, volatile LAS unsigned* st) {
    asm volatile("s_waitcnt vmcnt(0)" ::: "memory");
    __syncthreads();
    if (threadIdx.x == 0) {
        if (!same) { __builtin_amdgcn_fence(__ATOMIC_RELEASE, "agent"); asm volatile("s_waitcnt vmcnt(0)" ::: "memory"); }
        const unsigned old = xb_add(cnt, 1u);
        st[0] = (old / n + 1u) * n;
    }
}
__device__ __forceinline__ void group_wait(unsigned* cnt, unsigned* tmo, volatile LAS unsigned* st) {
    if (threadIdx.x == 0) {
        const unsigned target = st[0];
        XB_SPIN(xb_ld(cnt) < target, tmo);
        __builtin_amdgcn_fence(__ATOMIC_ACQUIRE, "agent");
        asm volatile("s_waitcnt vmcnt(0)" ::: "memory");
    }
    __syncthreads();
}
#ifndef CFG_ALIGN
#define CFG_ALIGN true
#endif
#ifndef CFG_ALIGN1
#define CFG_ALIGN1 true
#endif
#ifndef CFG_SP2
#define CFG_SP2 true
#endif
#ifndef PROBE_MASK
#define PROBE_MASK 0
#endif
constexpr size_t MiB = 1u << 20;
constexpr size_t WS_CTL = 0, CTL_ZERO_BYTES = 3 * MiB, WS_SSQ = 1 * MiB, WS_WLR = 2 * MiB + 512 * 1024;
constexpr size_t WS_WIN = 3 * MiB, WS_WBR = 14 * MiB, WS_WO = 16 * MiB, WS_WUP = 18 * MiB, WS_WDN = 26 * MiB;
constexpr size_t WS_XN = 35 * MiB, WS_PROJ = 67 * MiB, WS_DSS = 243 * MiB, WS_DT = 251 * MiB, WS_OI = 259 * MiB, WS_END = 291 * MiB;
static_assert(WS_WIN - WS_WLR == WOF_IN * 2 && WS_WBR - WS_WLR == WOF_BR * 2 && WS_WO - WS_WLR == WOF_O * 2 && WS_WUP - WS_WLR == WOF_UP * 2 && WS_WDN - WS_WLR == WOF_DN * 2, "weight offsets");
static_assert((size_t)NIN * DM * 2 <= WS_WBR - WS_WIN && (size_t)M * DM * 2 <= WS_PROJ - WS_XN && (size_t)(M / 256) * PBE * 2 <= WS_DSS - WS_PROJ && 256 * LDH <= PBE && (size_t)NUNIT * 8192 * 2 <= WS_DT - WS_DSS && (size_t)NUNIT * 64 * 4 <= WS_OI - WS_DT && (size_t)NITEM * 8192 * 4 <= WS_END - WS_OI && (size_t)9 * M * 8 <= 2 * MiB && WS_WDN + (size_t)DM * LDH * 2 <= WS_XN, "d_ws map");
constexpr int CW_BAR = 4096;
constexpr int CW_QUAD = 16384, CW_XCC = 32768, CW_BATCH = 24576;
constexpr int RS_OFF = 131072;
constexpr int RING_BYTES = 147456, MISC_OFF = RING_BYTES + 320, LDS_BYTES = RING_BYTES + 1024;
static_assert(ATT_END <= RING_BYTES && GA_END <= RING_BYTES && GB_END <= RING_BYTES && LR_END <= RING_BYTES && pg8::STAGE_BYTES <= RING_BYTES && NW * CONV_SCR <= RING_BYTES, "LDS map");

struct MergeOrder {
    pg8::StaticOrder so;
    __device__ __forceinline__ bool next(int i, pg8::Unit& u) const { pg8::Unit v; if (!so.next(i >> 1, v)) return false; const int br = i & 1; u.pm = v.pm + br * (M / 256); u.pn = v.pn + br * 4; return true; }
    __device__ __forceinline__ void a_ready(const pg8::Unit&) const {}
    __device__ __forceinline__ void done(const pg8::Unit&) const {}
};

__device__ __forceinline__ int lane_id() { int l; asm volatile("v_mbcnt_lo_u32_b32 %0, -1, 0\n\tv_mbcnt_hi_u32_b32 %0, -1, %0" : "=v"(l)); return l; }
struct Args { const float* in[13]; float* out; unsigned char* ws; };

__global__ void __launch_bounds__(NT, 2) mega_fwd(Args a) {
    extern __shared__ __attribute__((aligned(16))) unsigned char lds_raw[];
    LAS unsigned char* lds = (LAS unsigned char*)lds_raw;
    const int tid0 = threadIdx.x, lane0 = tid0 & 63, wave = __builtin_amdgcn_readfirstlane(tid0 >> 6);
    const int G = gridDim.x, bx0 = blockIdx.x, vcu0 = (G % 8 == 0) ? (bx0 % 8) * (G / 8) + bx0 / 8 : bx0;
    const int ngw = G * NW;
    for (int u = tid0; u < (LDS_BYTES - RING_BYTES) / 4; u += NT) ((LAS unsigned*)(lds + RING_BYTES))[u] = 0u;
    __syncthreads();
    unsigned char* ws = a.ws;
    Ptrs P;
    P.x = a.in[0]; P.mix_g = a.in[1]; P.w_in = a.in[2]; P.relb = a.in[3]; P.wglr = a.in[4]; P.bgate = a.in[5]; P.gng = a.in[6]; P.wbr = a.in[7]; P.wout = a.in[8]; P.mlp_g = a.in[9]; P.wup = a.in[10]; P.wdn = a.in[11]; P.fin_g = a.in[12];
    P.res = a.out;
    P.wts = (bf16_t*)(ws + WS_WLR); P.XN = (bf16_t*)(ws + WS_XN); P.proj = (bf16_t*)(ws + WS_PROJ);
    P.DSS = (bf16_t*)(ws + WS_DSS); P.DT = (float*)(ws + WS_DT); P.OI = (float*)(ws + WS_OI); P.SSQ = (unsigned long long*)(ws + WS_SSQ);
    XcdBarrier bar = xcd_barrier_post((unsigned*)(ws + WS_CTL) + CW_BAR, (volatile LAS unsigned*)(lds + MISC_OFF) + 8);
    LAS float* scr = (LAS float*)(lds + wave * CONV_SCR);
    unsigned* ctlw = (unsigned*)(ws + WS_CTL);
    const int pm0 = 8 * (bx0 % 8) + (bx0 / 8) % 8, pn0 = bx0 / 64;
    const bool quad_ok = (G == 256);
    if (tid0 == 0) __hip_atomic_store(ctlw + CW_XCC + bx0, bar.x + 1u, __ATOMIC_RELAXED, __HIP_MEMORY_SCOPE_AGENT);
    volatile LAS unsigned* qflag = (volatile LAS unsigned*)(lds + MISC_OFF) + 16;

    if (PROBE_MASK & 128) phase_x0(P, vcu0 * NW + wave, ngw, lane0);
    phase_x0(P, vcu0 * NW + wave, ngw, lane0);
    conv_phase(P, -1, 0, scr, vcu0 * NW + wave, ngw, lane0);
    xcd_barrier(bar);
    if (tid0 == 0) { unsigned same = quad_ok ? 1u : 0u; const unsigned me = __hip_atomic_load(ctlw + CW_XCC + bx0, __ATOMIC_RELAXED, __HIP_MEMORY_SCOPE_AGENT);
        for (int q = 0; q < 4; ++q) if (__hip_atomic_load(ctlw + CW_XCC + (bx0 % 64) + 64 * q, __ATOMIC_RELAXED, __HIP_MEMORY_SCOPE_AGENT) != me) same = 0u;
        unsigned sameb = quad_ok ? 1u : 0u;
        for (int q = 0; q < 32; ++q) if (__hip_atomic_load(ctlw + CW_XCC + (bx0 % 8) + 8 * q, __ATOMIC_RELAXED, __HIP_MEMORY_SCOPE_AGENT) != me) sameb = 0u;
        qflag[0] = same; qflag[1] = sameb; }
    __syncthreads();
    const unsigned same_xcd = qflag[0], same_batch = qflag[1];
    unsigned* bcnt = ctlw + CW_BATCH + 64 * (bx0 % 8);
    volatile LAS unsigned* bst = (volatile LAS unsigned*)(lds + MISC_OFF) + 20;
    unsigned* qcnt = ctlw + CW_QUAD + 64 * pm0; unsigned* qtmo = (unsigned*)(ws + WS_CTL) + CW_BAR;
#define SEAM(q) do { if ((q) && quad_ok) quad_barrier(qcnt, qtmo, same_xcd); else xcd_barrier(bar); } while (0)
#pragma unroll 1
    for (int l = 0; l < DEPTH; ++l) {
        int bx = bx0, vcu = vcu0, lane = lane_id(), pm = pm0, pn = pn0; OPAQUE_S(bx); OPAQUE_S(vcu); OPAQUE_V(lane); OPAQUE_S(pm); OPAQUE_S(pn);
        const int gw = vcu * NW + wave;
        {
            if (quad_ok) { if (PROBE_MASK & 8192) lr_item(P, l, lds, 4 * pm + pn); lr_item(P, l, lds, 4 * pm + pn); }
            else for (int u = vcu; u < BATCH * NCH; u += G) lr_item(P, l, lds, u);
            pg8::Gemm g{P.XN, P.Win_t(), M, NIN, DM, DM, DM, (size_t)256 * DM * 2, 1 << 30, 0}; pg8::StaticOrder S; S.init(M, NIN, G, bx);
            pg8::Unit u0; S.next(0, u0); LAS float* rsl = (LAS float*)(lds + RS_OFF);
            int tid1 = wave * 64 + lane_id(); OPAQUE_V(tid1);
            if (tid1 < 256) rsl[tid1] = ssq_rstd(P.SSQ[(size_t)(2 * l) * M + u0.pm * 256 + tid1]);
            __syncthreads();
            EpiIn E{P, P.SSQ + (size_t)(2 * l) * M, rsl, u0.pm};
            if (PROBE_MASK & 1) { pg8::gemm_phase<EpiIn, pg8::StaticOrder, CFG_ALIGN, CFG_SP2>(lds, g, S, E); __syncthreads(); }
            pg8::gemm_phase<EpiIn, pg8::StaticOrder, CFG_ALIGN, CFG_SP2>(lds, g, S, E);
        }
        if (quad_ok) { xcd_barrier_arrive(bar); group_barrier(bcnt, qtmo, same_batch, 32u); }
        else xcd_barrier(bar);
        {
            if (quad_ok) { if (PROBE_MASK & 2) gla_a_unit<false>(P, lds, (((pm >> 3) * 4 + pn) * NSC) + (pm & 7)); gla_a_unit(P, lds, (((pm >> 3) * 4 + pn) * NSC) + (pm & 7)); }
            else for (int u = vcu; u < NUNIT; u += G) gla_a_unit(P, lds, u);
            if (quad_ok) xcd_barrier_wait(bar);
            if (PROBE_MASK & 8) conv_phase(P, l, l + 1, scr, gw, ngw, lane);
            conv_phase(P, l, l + 1, scr, gw, ngw, lane);
            xcd_barrier_arrive(bar);
            if (quad_ok) { for (int hg = 0; hg < 2; ++hg) { if (PROBE_MASK & 4) att_unit<false>(P, l, lds, pm >> 3, 4 * (pm & 7) + pn, hg); att_unit(P, l, lds, pm >> 3, 4 * (pm & 7) + pn, hg); } }
            else for (int u = vcu; u < BATCH * NCH * 2; u += G) { const int c = u % NCH, bh = u / NCH; att_unit(P, l, lds, bh >> 1, c, bh & 1); }
            xcd_barrier_wait(bar);
            if (quad_ok) group_arrive(bcnt, same_batch, 32u, bst); else xcd_barrier_arrive(bar);
            if (quad_ok) { if (PROBE_MASK & 16) gla_b_unit(P, l, lds, (((pm >> 3) * 4 + pn) * NSC) + (pm & 7)); gla_b_unit(P, l, lds, (((pm >> 3) * 4 + pn) * NSC) + (pm & 7)); }
            else for (int u = vcu; u < NUNIT; u += G) gla_b_unit(P, l, lds, u);
            if (quad_ok) group_wait(bcnt, qtmo, bst); else xcd_barrier_wait(bar);
        }
        SEAM(1);
        {
            pg8::Gemm g{P.QA(), P.Wbr_t(), 2 * M, 2048, 512, 512, 512, (size_t)PBE * 2, M / 256, (size_t)(O_VB - O_QA) * 2};     MergeOrder S; S.so.init(M, DM, G, bx);
            EpiMerge E{P};
            if (PROBE_MASK & 32) { pg8::gemm_phase<EpiMerge, MergeOrder, CFG_ALIGN, CFG_SP2>(lds, g, S, E); __syncthreads(); }
            pg8::gemm_phase<EpiMerge, MergeOrder, CFG_ALIGN, CFG_SP2>(lds, g, S, E);
        }
        SEAM(1);
        {
            pg8::Gemm g{P.MERGED(), P.Wo_t(), M, DM, DM, DM, DM, (size_t)PBE * 2, 1 << 30, 0}; pg8::StaticOrder S; S.init(M, DM, G, bx);
            EpiRes E{P, P.SSQ + (size_t)(2 * l + 1) * M};
            pg8::gemm_phase<EpiRes, pg8::StaticOrder, CFG_ALIGN1, CFG_SP2>(lds, g, S, E);
        }
        SEAM(1);
        {
            pg8::Gemm g{P.XN, P.Wup_t(), M, DFF, DM, DM, DM, (size_t)256 * DM * 2, 1 << 30, 0}; pg8::StaticOrder S; S.init(M, DFF, G, bx);
            pg8::Unit u0; S.next(0, u0); LAS float* rsl = (LAS float*)(lds + RS_OFF);
            int tid5 = wave * 64 + lane_id(); OPAQUE_V(tid5);
            if (tid5 < 256) rsl[tid5] = ssq_rstd(P.SSQ[(size_t)(2 * l + 1) * M + u0.pm * 256 + tid5]);
            __syncthreads();
            EpiUp E{P, P.SSQ + (size_t)(2 * l + 1) * M, rsl, u0.pm};
            if (PROBE_MASK & 64) { pg8::gemm_phase<EpiUp, pg8::StaticOrder, CFG_ALIGN, CFG_SP2>(lds, g, S, E); __syncthreads(); }
            pg8::gemm_phase<EpiUp, pg8::StaticOrder, CFG_ALIGN, CFG_SP2>(lds, g, S, E);
        }
        SEAM(1);
        {
            pg8::Gemm g{P.HID(), P.Wdn_t(), M, DM, DFF, LDH, LDH, (size_t)PBE * 2, 1 << 30, 0}; pg8::StaticOrder S; S.init(M, DM, G, bx);
            EpiRes E{P, P.SSQ + (size_t)(2 * l + 2) * M};
            pg8::gemm_phase<EpiRes, pg8::StaticOrder, CFG_ALIGN1, CFG_SP2>(lds, g, S, E);
        }
        SEAM(1);
    }
    int lane_f = lane_id(), pmf = pm0; OPAQUE_V(lane_f); OPAQUE_S(pmf);
    if (quad_ok) phase_final(P, pmf * 256 + pn0 * 64 + wave, pmf * 256 + pn0 * 64 + 64, NW, lane_f);
    else phase_final(P, vcu0 * NW + wave, M, ngw, lane_f);
#undef SEAM
}

extern "C" void kernel_launch(void* const* d_in, const int* in_sizes, int n_in, void* d_out, int out_size, void* d_ws, size_t ws_size, hipStream_t stream) {
    static int grid = 0;
    if (grid == 0) {
        if (n_in != 13 || out_size != M * DM || ws_size < WS_END) { fprintf(stderr, "kernel_launch: unexpected shapes (n_in %d, out %d, ws %zu < %zu)\n", n_in, out_size, ws_size, (size_t)WS_END); grid = -1; return; }
        int dev = 0, cus = 0, per_cu = 0;
        if (hipGetDevice(&dev) != hipSuccess || hipDeviceGetAttribute(&cus, hipDeviceAttributeMultiprocessorCount, dev) != hipSuccess) { grid = -1; return; }
        if (hipFuncSetAttribute((const void*)mega_fwd, hipFuncAttributeMaxDynamicSharedMemorySize, LDS_BYTES) != hipSuccess) { fprintf(stderr, "kernel_launch: hipFuncSetAttribute failed\n"); grid = -1; return; }
        if (hipOccupancyMaxActiveBlocksPerMultiprocessor(&per_cu, (const void*)mega_fwd, NT, LDS_BYTES) != hipSuccess || per_cu < 1) fprintf(stderr, "kernel_launch: occupancy query says %d blocks/CU\n", per_cu);
        (void)hipGetLastError();
        grid = cus;
    }
    if (grid < 0) return;
    (void)hipMemsetAsync((char*)d_ws + WS_CTL, 0, CTL_ZERO_BYTES, stream);
    Args a{};
    for (int i = 0; i < 13; ++i) a.in[i] = (const float*)d_in[i];
    a.out = (float*)d_out; a.ws = (unsigned char*)d_ws;
    hipLaunchKernelGGL(mega_fwd, dim3(grid), dim3(NT), LDS_BYTES, stream, a);
}
```

```cpp
#include <hip/hip_runtime.h>
#include <cstdio>
#include <cstdint>
#ifndef CFG_BATCH
#define CFG_BATCH 8
#endif
#ifndef CFG_SEQ
#define CFG_SEQ 2048
#endif
constexpr int BATCH = CFG_BATCH, SEQ = CFG_SEQ, DM = 1024, DEPTH = 4, NCH = SEQ / 64, M = BATCH * SEQ;
constexpr int O_QA = 0, O_VB = O_QA + 256 * 512, O_KA = O_VB + 256 * 512, O_VA = O_KA + 256 * 512, O_QB = O_VA + 256 * 512, O_KB = O_QB + 256 * 256, O_RB = O_KB + 256 * 256, O_LA = O_RB + 256 * 512,
              O_GA = O_LA + 256 * 512  , O_GB = O_GA + 256 * 1024, PBE = O_GB + 256 * 1024;
constexpr int LDH = 4096 + 64;
constexpr int NREL = 257, DFF = 4096, INC = 5136, NIN = 5120;
constexpr int NITEM = BATCH * NCH * 4;
constexpr float EPS = 1e-6f, LOG2E = 1.4426950408889634f, LN2 = 0.6931471805599453f;
constexpr int NW = 8, NT = 512;

typedef unsigned short bf16_t;
typedef unsigned u32x2 __attribute__((ext_vector_type(2)));
typedef unsigned u32x4 __attribute__((ext_vector_type(4)));
typedef float f32x2 __attribute__((ext_vector_type(2)));

#ifdef EMU
#define DEV inline
#define LAS
#define MFMA32(a, b, c) emu_mfma32(a, b, c)
#define MFMA16(a, b, c) emu_mfma16(a, b, c)
#define SHFL_XOR(v, m) emu_shfl_xor(v, m)
#define TR_READ(p) emu_tr_read((const void*)(p))
#define WAVE_LDS_SYNC() emu::wave_sync()
#define EXP2F(x) exp2f(x)
#define LOG2F(x) log2f(x)
#define RCPF(x) (1.0f / (x))
#define RSQF(x) (1.0f / sqrtf(x))
#define ATOMIC_ADD_U64(p, v) (*(p) += (v))
#define OPAQUE_V(x)
#define OPAQUE_S(x)
#define SCHED_FENCE()
#define BPERM(srclane, v) emu_shfl((v), (srclane))
#define DPP_SHR_F(v, n) emu_row_shr((v), (n))
#define ADD_INPLACE(x, y) ((x) += (y))
#define NT_LOAD_F4(p) (*(const f32x4*)(p))
#define NT_STORE_F4(p, v) (*(f32x4*)(p) = (v))
#define WAVE_ANY(c) emu_wave_any(c)
#define ST16_WT(p, v) (*(u32x4*)(p) = (v))
DEV unsigned cvtpk(float lo, float hi) { auto f = [](float x) { unsigned u; memcpy(&u, &x, 4); return (u + 0x7fffu + ((u >> 16) & 1u)) >> 16; }; return f(lo) | (f(hi) << 16); }
#else
#define DEV __device__ __forceinline__
#define LAS __attribute__((address_space(3)))
typedef short bf16x8 __attribute__((ext_vector_type(8)));
typedef short s16x4 __attribute__((ext_vector_type(4)));
typedef float f32x16 __attribute__((ext_vector_type(16)));
typedef float f32x4 __attribute__((ext_vector_type(4)));
typedef short v4i16_t __attribute__((ext_vector_type(4)));
typedef __bf16 bf16x2_t __attribute__((ext_vector_type(2)));
#define MFMA32(a, b, c) __builtin_amdgcn_mfma_f32_32x32x16_bf16(a, b, c, 0, 0, 0)
#define MFMA16(a, b, c) __builtin_amdgcn_mfma_f32_16x16x32_bf16(a, b, c, 0, 0, 0)
#define SHFL_XOR(v, m) __shfl_xor(v, m)
#define TR_READ(p) __builtin_bit_cast(s16x4, __builtin_amdgcn_ds_read_tr16_b64_v4i16((LAS v4i16_t*)(p)))
#define WAVE_LDS_SYNC() asm volatile("s_waitcnt lgkmcnt(0)" ::: "memory")
#define EXP2F(x) __builtin_amdgcn_exp2f(x)
#define LOG2F(x) __builtin_amdgcn_logf(x)
#define RCPF(x) __builtin_amdgcn_rcpf(x)
#define RSQF(x) __builtin_amdgcn_rsqf(x)
#define ATOMIC_ADD_U64(p, v) atomicAdd((p), (v))
#define OPAQUE_V(x) asm volatile("" : "+v"(x))
#define OPAQUE_S(x) asm volatile("" : "+s"(x))
#define BPERM(srclane, v) ((unsigned)__builtin_amdgcn_ds_bpermute((srclane) * 4, (int)(v)))
#define DPP_SHR_F(v, n) __builtin_bit_cast(float, __builtin_amdgcn_update_dpp(0, __builtin_bit_cast(int, (float)(v)), 0x110 + (n), 0xf, 0xf, true))
#define ADD_INPLACE(x, y) asm("v_add_f32_e32 %0, %1, %0" : "+v"(x) : "v"(y))
#define NT_LOAD_F4(p) __builtin_nontemporal_load((const f32x4*)(p))
#define NT_STORE_F4(p, v) __builtin_nontemporal_store((v), (f32x4*)(p))
#define WAVE_ANY(c) (__builtin_amdgcn_ballot_w64(c) != 0ull)
#define SCHED_FENCE() __builtin_amdgcn_sched_barrier(0)
#define ST16_WT(p, v) (*(u32x4*)(p) = (v))
DEV unsigned cvtpk(float lo, float hi) { f32x2 v = {lo, hi}; bf16x2_t b = __builtin_convertvector(v, bf16x2_t); return __builtin_bit_cast(unsigned, b); }
#endif
typedef LAS unsigned char* lds_t;
DEV size_t pofs(size_t row, int ld) { return (row >> 8) * (size_t)PBE + (row & 255) * (size_t)ld; }
DEV size_t pofs_f(size_t row, int ld) { return (row >> 8) * (size_t)(PBE / 2) + (row & 255) * (size_t)ld; }

DEV float bf2f(bf16_t b) { return __builtin_bit_cast(float, (unsigned)b << 16); }
DEV float bflo(unsigned u) { return __builtin_bit_cast(float, u << 16); }
DEV float bfhi(unsigned u) { return __builtin_bit_cast(float, u & 0xffff0000u); }
DEV int crow(int r, int hi) { return (r & 3) + 8 * (r >> 2) + 4 * hi; }
constexpr float SSQ_SCALE = 16777216.0f, SSQ_INV = 1.0f / 16777216.0f;
DEV float ssq_rstd(unsigned long long v) { return RSQF((float)v * (SSQ_INV / DM) + EPS); }
DEV u32x4 pack8(const f32x4 a, const f32x4 b) { u32x4 w; w[0] = cvtpk(a[0], a[1]); w[1] = cvtpk(a[2], a[3]); w[2] = cvtpk(b[0], b[1]); w[3] = cvtpk(b[2], b[3]); return w; }
DEV void unpack8(const u32x4 w, f32x4& a, f32x4& b) { a[0] = bflo(w[0]); a[1] = bfhi(w[0]); a[2] = bflo(w[1]); a[3] = bfhi(w[1]); b[0] = bflo(w[2]); b[1] = bfhi(w[2]); b[2] = bflo(w[3]); b[3] = bfhi(w[3]); }
DEV u32x4 quad_rows(const u32x4 w, int lane) { const int src = (lane >> 2) + 16 * (lane & 3); u32x4 r; r[0] = BPERM(src, w[0]); r[1] = BPERM(src, w[1]); r[2] = BPERM(src, w[2]); r[3] = BPERM(src, w[3]); return r; }
DEV float bperm_f(int src, float v) { return __builtin_bit_cast(float, BPERM(src, __builtin_bit_cast(unsigned, v))); }
DEV f32x4 quad_rows_f(const f32x4 w, int lane) { const int src = (lane >> 2) + 16 * (lane & 3); f32x4 r; r[0] = bperm_f(src, w[0]); r[1] = bperm_f(src, w[1]); r[2] = bperm_f(src, w[2]); r[3] = bperm_f(src, w[3]); return r; }
DEV float sigmoidf_(float v) { return RCPF(1.0f + EXP2F(-v * LOG2E)); }

constexpr size_t WOF_LR = 0, WOF_IN = 256 * 1024, WOF_BR = WOF_IN + (size_t)11 * 512 * 1024, WOF_O = WOF_BR + (size_t)2 * 512 * 1024, WOF_UP = WOF_O + (size_t)2 * 512 * 1024, WOF_DN = WOF_UP + (size_t)8 * 512 * 1024;
struct Ptrs {
    const float *x, *mix_g, *w_in, *relb, *wglr, *bgate, *gng, *wbr, *wout, *mlp_g, *wup, *wdn, *fin_g;
    float* res;
    bf16_t *proj, *wts, *XN, *DSS; float *OI, *DT; unsigned long long* SSQ;
    DEV bf16_t* QA() const { return proj + O_QA; } DEV bf16_t* VB() const { return proj + O_VB; } DEV bf16_t* KA() const { return proj + O_KA; } DEV bf16_t* VA() const { return proj + O_VA; }
    DEV bf16_t* QB() const { return proj + O_QB; } DEV bf16_t* KB() const { return proj + O_KB; } DEV bf16_t* RB() const { return proj + O_RB; } DEV bf16_t* LA() const { return proj + O_LA; }
    DEV bf16_t* GA() const { return proj + O_GA; } DEV bf16_t* GB() const { return proj + O_GB; } DEV bf16_t* T() const { return proj + O_KA; } DEV bf16_t* MERGED() const { return proj + O_QB; } DEV bf16_t* HID() const { return proj; }
    DEV bf16_t* Wlr_t() const { return wts + WOF_LR; } DEV bf16_t* Win_t() const { return wts + WOF_IN; } DEV bf16_t* Wbr_t() const { return wts + WOF_BR; } DEV bf16_t* Wo_t() const { return wts + WOF_O; }
    DEV bf16_t* Wup_t() const { return wts + WOF_UP; } DEV bf16_t* Wdn_t() const { return wts + WOF_DN; }
};

constexpr int ATT_KSTR = 528, ATT_VSTR = 576, ATT_KT = 64 * ATT_KSTR, ATT_VT = 64 * ATT_VSTR;
constexpr int ATT_K0 = 0, ATT_V0 = 2 * ATT_KT, ATT_BT = ATT_V0 + 2 * ATT_VT, ATT_END = ATT_BT + 4 * 260 * 4;
constexpr int G1_QSTR = 144, G1_ESTR = 192, G1_VSTR = 320;
constexpr int G1_QT = 0, G1_KT = G1_QT + 64 * G1_QSTR, G1_KE = G1_KT + 64 * G1_QSTR, G1_V = G1_KE + 64 * G1_ESTR, G1_TOT = G1_V + 64 * G1_VSTR, G1_END = G1_TOT + 8 * 64 * 4;
constexpr int CONV_SCR = 64 * 33 * 4;

DEV void phase_x0(const Ptrs& P, int gw, int ngw, int lane) {
    for (int row = gw; row < M; row += ngw) {
        const f32x4* xr = (const f32x4*)(P.x + (size_t)row * DM); u32x2* xn = (u32x2*)(P.XN + (size_t)row * DM);
        float s = 0.f;
#pragma unroll
        for (int j = 0; j < 4; ++j) { const f32x4 v = NT_LOAD_F4(xr + lane + 64 * j); s += (v[0] * v[0] + v[1] * v[1]) + (v[2] * v[2] + v[3] * v[3]);
            u32x2 o; o[0] = cvtpk(v[0], v[1]); o[1] = cvtpk(v[2], v[3]); xn[lane + 64 * j] = o; }
#pragma unroll
        for (int o = 1; o < 64; o <<= 1) s += SHFL_XOR(s, o);
        if (lane == 0) P.SSQ[row] = (unsigned long long)(s * SSQ_SCALE);
    }
}

DEV void phase_final(const Ptrs& P, int row_first, int row_end, int row_step, int lane) {
    const unsigned long long* ssq = P.SSQ + (size_t)8 * M;
    for (int row = row_first; row < row_end; row += row_step) {
        f32x4* rr = (f32x4*)(P.res + (size_t)row * DM); const f32x4* g = (const f32x4*)P.fin_g; const u32x2* xn = (const u32x2*)(P.XN + (size_t)row * DM);
        const float rs = ssq_rstd(ssq[row]);
#pragma unroll
        for (int j = 0; j < 4; ++j) { const u32x2 w = xn[lane + 64 * j]; f32x4 v = {bflo(w[0]), bfhi(w[0]), bflo(w[1]), bfhi(w[1])}; const f32x4 gg = g[lane + 64 * j]; v = v * rs * gg; NT_STORE_F4(rr + lane + 64 * j, v); }
    }
}

struct ConvD { const float* W; bf16_t* WT; const float* gain; float scale; int ldw, K, ldt, k0, n0, gate; };
DEV ConvD conv_decode(const Ptrs& P, int lrest, int lin, int n_rest, int n_in, int it) {
    ConvD d; int r = it, nblk; d.gain = nullptr; d.scale = 1.f; d.gate = 0;
    if (r < n_rest) {
        if (r < 256) { d.W = P.wbr + (size_t)(2 * lrest) * 512 * DM; d.ldw = DM; d.K = 512; nblk = 32; d.WT = P.Wbr_t(); }
        else if (r < 512) { r -= 256; d.W = P.wbr + (size_t)(2 * lrest + 1) * 512 * DM; d.ldw = DM; d.K = 512; nblk = 32; d.WT = P.Wbr_t() + (size_t)DM * 512; }
        else if (r < 1024) { r -= 512; d.W = P.wout + (size_t)lrest * DM * DM; d.ldw = DM; d.K = DM; nblk = 32; d.WT = P.Wo_t(); }
        else if (r < 3072) { r -= 1024; d.W = P.wup + (size_t)lrest * DM * DFF; d.ldw = DFF; d.K = DM; nblk = 128; d.WT = P.Wup_t(); d.gain = P.mlp_g + lrest * DM; }
        else { r -= 3072; d.W = P.wdn + (size_t)lrest * DFF * DM; d.ldw = DM; d.K = DFF; nblk = 32; d.WT = P.Wdn_t(); }
    } else {
        r -= n_rest; const float* W0 = P.w_in + (size_t)lin * DM * INC; d.gain = P.mix_g + lin * DM; d.ldw = INC; d.K = DM; d.W = W0; d.WT = P.Win_t(); nblk = 1;
        if (r >= n_in) { d.gate = 1; r -= n_in; }
        else if (r < 256) { nblk = 16; d.scale = 0.125f * LOG2E; }
        else if (r < 768) { r -= 256; d.W = W0 + 512; nblk = 32; d.WT = P.Win_t() + (size_t)512 * DM; }
        else if (r < 896) { r -= 768; d.W = W0 + 1536; nblk = 8; d.WT = P.Win_t() + (size_t)1536 * DM; d.scale = 0.125f; }
        else if (r < 1536) { r -= 896; d.W = W0 + 1792; nblk = 40; d.WT = P.Win_t() + (size_t)1792 * DM; }
        else { r -= 1536; d.W = W0 + 3088; nblk = 64; d.WT = P.Win_t() + (size_t)3072 * DM; }
    }
    d.ldt = d.K == DFF ? LDH : d.K;
    if (d.gate) { d.k0 = r; d.n0 = 0; } else { d.k0 = 64 * (r / nblk); d.n0 = 32 * (r % nblk); }
    return d;
}
DEV void conv_load(const ConvD& d, f32x4 (&v)[8], int lane) {
    const float* src = d.W + (size_t)(d.k0 + (lane >> 3)) * d.ldw + d.n0 + 4 * (lane & 7);
#pragma unroll
    for (int i = 0; i < 8; ++i) v[i] = NT_LOAD_F4(src + (size_t)(8 * i) * d.ldw);
}
DEV void conv_finish(const ConvD& d, const f32x4 (&v)[8], LAS float* scr, int lane) {
#pragma unroll
    for (int i = 0; i < 8; ++i) { const int kk = 8 * i + (lane >> 3); const float g = d.gain ? d.gain[d.k0 + kk] * d.scale : d.scale; LAS float* s = scr + kk * 33 + 4 * (lane & 7);
        s[0] = v[i][0] * g; s[1] = v[i][1] * g; s[2] = v[i][2] * g; s[3] = v[i][3] * g; }
    WAVE_LDS_SYNC();
    const int c = lane & 7;
#pragma unroll
    for (int j = 0; j < 4; ++j) { const int n = (lane >> 3) + 8 * j; const LAS float* s = scr + (8 * c) * 33 + n;
        u32x4 o; o[0] = cvtpk(s[0 * 33], s[1 * 33]); o[1] = cvtpk(s[2 * 33], s[3 * 33]); o[2] = cvtpk(s[4 * 33], s[5 * 33]); o[3] = cvtpk(s[6 * 33], s[7 * 33]);
        *(u32x4*)(d.WT + (size_t)(d.n0 + n) * d.ldt + d.k0 + 8 * c) = o; }
    WAVE_LDS_SYNC();
}
DEV void conv_lr_item(const float* w_in_l, const float* gain, bf16_t* Wlr_t, int it, int lane) {
#pragma unroll 1
    for (int j = 0; j < 4; ++j) { const int k = it * 256 + j * 64 + lane; const float g = gain[k]; const f32x4* src = (const f32x4*)(w_in_l + (size_t)k * INC + 3072);
#pragma unroll
        for (int q = 0; q < 4; ++q) { const f32x4 v = src[q];
#pragma unroll
            for (int e = 0; e < 4; ++e) Wlr_t[(size_t)(4 * q + e) * DM + k] = (bf16_t)(cvtpk(v[e] * g, 0.f) & 0xffffu); } }
}
DEV void conv_phase(const Ptrs& P, int lrest, int lin, LAS float* scr, int gw, int ngw, int lane) {
    const int n_rest = lrest >= 0 ? 5120 : 0, n_in = lin < DEPTH ? 2560 : 0, total = n_rest + n_in + (lin < DEPTH ? 4 : 0);
    int it = gw; if (it >= total) return;
    ConvD d0 = conv_decode(P, lrest, lin, n_rest, n_in, it), d1 = d0; f32x4 v0[8], v1[8];
    if (!d0.gate) conv_load(d0, v0, lane);
    bool have1 = it + ngw < total;
    if (have1) { d1 = conv_decode(P, lrest, lin, n_rest, n_in, it + ngw); if (!d1.gate) conv_load(d1, v1, lane); }
#pragma unroll 1
    for (;;) {
        const int it2 = it + 2 * ngw; const bool have2 = have1 && it2 < total; ConvD d2 = d1; f32x4 v2[8];
        if (have2) { d2 = conv_decode(P, lrest, lin, n_rest, n_in, it2); if (!d2.gate) conv_load(d2, v2, lane); }
        if (d0.gate) conv_lr_item(d0.W, d0.gain, P.Wlr_t(), d0.k0, lane); else conv_finish(d0, v0, scr, lane);
        if (!have1) break;
        d0 = d1; d1 = d2; it += ngw; have1 = have2;
#pragma unroll
        for (int i = 0; i < 8; ++i) { v0[i] = v1[i]; v1[i] = v2[i]; }
    }
}

constexpr int LR_PART = 0, LR_LRB = 8 * 64 * 16 * 4, LR_END = LR_LRB + 64 * 16 * 4;
DEV void lr_item(const Ptrs& P, int layer, lds_t lds, int bc) {
    int tid_ = threadIdx.x; OPAQUE_V(tid_); const int tid = tid_, lane = tid & 63, w = tid >> 6, l15 = lane & 15, lq = lane >> 4;
    const size_t row0 = (size_t)bc * 64;
    f32x4 acc[4];
#pragma unroll
    for (int m = 0; m < 4; ++m) acc[m] = (f32x4){0.f, 0.f, 0.f, 0.f};
#pragma unroll
    for (int ks = 0; ks < 4; ++ks) { const int k = 128 * w + 32 * ks + 8 * lq;
        const bf16x8 b = *(const bf16x8*)(P.Wlr_t() + (size_t)l15 * DM + k);
#pragma unroll
        for (int m = 0; m < 4; ++m) { const bf16x8 a = *(const bf16x8*)(P.XN + (row0 + 16 * m + l15) * DM + k); acc[m] = MFMA16(a, b, acc[m]); } }
    LAS float* part = (LAS float*)(lds + LR_PART); LAS float* lrb = (LAS float*)(lds + LR_LRB);
#pragma unroll
    for (int m = 0; m < 4; ++m)
#pragma unroll
        for (int r = 0; r < 4; ++r) part[(w * 64 + 16 * m + 4 * lq + r) * 16 + l15] = acc[m][r];
    __syncthreads();
    const unsigned long long* ssq = P.SSQ + (size_t)(2 * layer) * M;
#pragma unroll
    for (int i = 0; i < 2; ++i) { const int o = tid + NT * i, t = o >> 4; float s = 0.f;
#pragma unroll
        for (int ww = 0; ww < 8; ++ww) s += part[ww * 1024 + o];
        lrb[o] = s * ssq_rstd(ssq[row0 + t]); }
    __syncthreads();
    const int l31 = lane & 31, hi = lane >> 5, j = 32 * w + l31;
    bf16x8 bw;
    { float wv[8];
#pragma unroll
      for (int i = 0; i < 8; ++i) wv[i] = P.wglr[(size_t)(layer * 16 + 8 * hi + i) * 256 + j];
      u32x4 u; u[0] = cvtpk(wv[0], wv[1]); u[1] = cvtpk(wv[2], wv[3]); u[2] = cvtpk(wv[4], wv[5]); u[3] = cvtpk(wv[6], wv[7]); bw = __builtin_bit_cast(bf16x8, u); }
    const float bg = P.bgate[layer * 256 + j];
#pragma unroll
    for (int tb = 0; tb < 2; ++tb) {
        const f32x4 a0 = *(const LAS f32x4*)(lrb + (tb * 32 + l31) * 16 + 8 * hi), a1 = *(const LAS f32x4*)(lrb + (tb * 32 + l31) * 16 + 8 * hi + 4);
        const bf16x8 af = __builtin_bit_cast(bf16x8, pack8(a0, a1));
        f32x16 d;
#pragma unroll
        for (int r = 0; r < 16; ++r) d[r] = bg;
        d = MFMA32(af, bw, d);
#pragma unroll
        for (int r = 0; r < 16; r += 2) { float x[2];
#pragma unroll
            for (int e = 0; e < 2; ++e) { const float g = d[r + e]; x[e] = (fminf(g, 0.f) - LOG2F(1.0f + EXP2F(-fabsf(g) * LOG2E)) * LN2) * 0.0625f; }
            const int odd = lane & 1; const float got = SHFL_XOR(odd ? x[0] : x[1], 1);
            const unsigned pk = odd ? cvtpk(got, x[1]) : cvtpk(x[0], got);
            *(unsigned*)(P.LA() + pofs(row0 + tb * 32 + crow(r, hi) + odd, 256) + j - odd) = pk; } }
    __syncthreads();
}

template <bool STORE = true> DEV void att_unit(const Ptrs& P, int layer, lds_t lds, int b, int c, int hg) {
    int tid_ = threadIdx.x; OPAQUE_V(tid_); const int tid = tid_, lane = tid & 63, w = tid >> 6, hl = w >> 1, qb = w & 1, l31 = lane & 31, hi = lane >> 5;
    const int h = hg * 4 + hl; const size_t row0 = (size_t)b * SEQ;
    LAS float* bt = (LAS float*)(lds + ATT_BT);
    for (int i = tid; i < 4 * NREL; i += NT) { const int hh = i / NREL, j = i % NREL; bt[hh * 260 + j] = P.relb[(size_t)(layer * 8 + hg * 4 + hh) * NREL + j] * LOG2E; }
    const size_t qrow = row0 + c * 64 + qb * 32 + l31;
    bf16x8 qf[4];
#pragma unroll
    for (int ks = 0; ks < 4; ++ks) qf[ks] = *(const bf16x8*)(P.QA() + pofs(qrow, 512) + h * 64 + ks * 16 + hi * 8);
    f32x16 oT[2];
#pragma unroll
    for (int r = 0; r < 16; ++r) { oT[0][r] = 0.f; oT[1][r] = 0.f; }
    float mrun = -1e30f, lrun = 0.f;
    const int t0 = (c >= 8) ? 0 : 8 - c;
    u32x4 kreg[4], vreg[4];
    const unsigned gofs = (unsigned)((tid >> 5) * 512 + hg * 256 + (tid & 31) * 8), lkofs = (unsigned)((tid >> 5) * ATT_KSTR + (tid & 31) * 16), lvofs = (unsigned)((tid >> 5) * ATT_VSTR + (tid & 31) * 16);
#define ATT_LOAD(t) do { const bf16_t* kb_ = P.KA() + pofs(row0 + (size_t)(c - 8 + (t)) * 64, 512); const bf16_t* vb_ = kb_ + (O_VA - O_KA); _Pragma("unroll") for (int i = 0; i < 4; ++i) { \
        kreg[i] = *(const u32x4*)(kb_ + gofs + i * 16 * 512); vreg[i] = *(const u32x4*)(vb_ + gofs + i * 16 * 512); } } while (0)
#define ATT_STORE(buf) do { const lds_t kd_ = lds + ATT_K0 + (buf) * ATT_KT + lkofs, vd_ = lds + ATT_V0 + (buf) * ATT_VT + lvofs; _Pragma("unroll") for (int i = 0; i < 4; ++i) { \
        *(LAS u32x4*)(kd_ + i * 16 * ATT_KSTR) = kreg[i]; *(LAS u32x4*)(vd_ + i * 16 * ATT_VSTR) = vreg[i]; } } while (0)
    ATT_LOAD(t0); ATT_STORE(0);
    __syncthreads();
    for (int t = t0; t <= 8; ++t) {
        const int buf = (t - t0) & 1;
        if (t < 8) ATT_LOAD(t + 1);
        const lds_t Kb = lds + ATT_K0 + buf * ATT_KT + hl * 128, Vb = lds + ATT_V0 + buf * ATT_VT + hl * 128;
        f32x16 s[2];
#pragma unroll
        for (int kb2 = 0; kb2 < 2; ++kb2) { f32x16 acc;
#pragma unroll
            for (int r = 0; r < 16; ++r) acc[r] = 0.f;
#pragma unroll
            for (int ks = 0; ks < 4; ++ks) { const bf16x8 a = *(const LAS bf16x8*)(Kb + (kb2 * 32 + l31) * ATT_KSTR + (ks * 16 + hi * 8) * 2); acc = MFMA32(a, qf[ks], acc); }
            s[kb2] = acc; }
        const LAS float* bth = bt + hl * 260;
        float c0 = 0.f;
        if (t <= 5) c0 = bth[256];
        else { const int base = 512 + qb * 32 + l31 - t * 64;
#pragma unroll
            for (int kb2 = 0; kb2 < 2; ++kb2)
#pragma unroll
                for (int r = 0; r < 16; ++r) { int d = base - (kb2 * 32 + crow(r, hi)); d = d > 128 ? 128 : d; const float bv = bth[d + 128]; ADD_INPLACE(s[kb2][r], bv); } }
        float mx = s[0][0];
#pragma unroll
        for (int r = 0; r < 16; ++r) { mx = fmaxf(mx, s[0][r]); mx = fmaxf(mx, s[1][r]); }
        mx = fmaxf(mx, SHFL_XOR(mx, 32)) + c0;
        const bool up = mx > mrun + 8.0f;
        if (WAVE_ANY(up)) { const float mnew = up ? mx : mrun, alpha = EXP2F(mrun - mnew); mrun = mnew; lrun *= alpha;
#pragma unroll
            for (int r = 0; r < 16; ++r) { oT[0][r] *= alpha; oT[1][r] *= alpha; } }
        const f32x2 sh = {c0 - mrun, c0 - mrun}; f32x2 ps = {0.f, 0.f};
#pragma unroll
        for (int kb2 = 0; kb2 < 2; ++kb2)
#pragma unroll
            for (int r = 0; r < 16; r += 2) { const f32x2 v = (f32x2){s[kb2][r], s[kb2][r + 1]} + sh; const f32x2 e = {EXP2F(v[0]), EXP2F(v[1])}; s[kb2][r] = e[0]; s[kb2][r + 1] = e[1]; ps += e; }
        lrun += ps[0] + ps[1];
        bf16x8 pf[2][2];
#pragma unroll
        for (int kb2 = 0; kb2 < 2; ++kb2)
#pragma unroll
            for (int s2 = 0; s2 < 2; ++s2) { u32x4 u;
#pragma unroll
                for (int j = 0; j < 4; ++j) u[j] = cvtpk(s[kb2][8 * s2 + 2 * j], s[kb2][8 * s2 + 2 * j + 1]);
                pf[kb2][s2] = __builtin_bit_cast(bf16x8, u); }
#pragma unroll
        for (int db = 0; db < 2; ++db)
#pragma unroll
            for (int kb2 = 0; kb2 < 2; ++kb2)
#pragma unroll
                for (int s2 = 0; s2 < 2; ++s2) { const int keyb = kb2 * 32 + s2 * 16 + 4 * hi + ((lane & 15) >> 2), colb = db * 32 + 16 * ((lane >> 4) & 1) + 4 * (lane & 3);
                    const s16x4 lo = TR_READ(Vb + keyb * ATT_VSTR + colb * 2), h4 = TR_READ(Vb + (keyb + 8) * ATT_VSTR + colb * 2);
                    const bf16x8 a = {lo[0], lo[1], lo[2], lo[3], h4[0], h4[1], h4[2], h4[3]};
                    oT[db] = MFMA32(a, pf[kb2][s2], oT[db]); }
        if (t < 8) ATT_STORE(buf ^ 1);
        __syncthreads();
    }
#undef ATT_LOAD
#undef ATT_STORE
    const float inv = RCPF(lrun + SHFL_XOR(lrun, 32));
    { const lds_t yt = lds + ATT_K0 + (qb * 32 + l31) * ATT_KSTR + (hl * 64 + 4 * hi) * 2;
#pragma unroll
      for (int db = 0; db < 2; ++db)
#pragma unroll
          for (int g4 = 0; g4 < 4; ++g4) { u32x2 o; o[0] = cvtpk(oT[db][4 * g4] * inv, oT[db][4 * g4 + 1] * inv); o[1] = cvtpk(oT[db][4 * g4 + 2] * inv, oT[db][4 * g4 + 3] * inv);
              *(LAS u32x2*)(yt + (db * 32 + 8 * g4) * 2) = o; } }
    __syncthreads();
    if (STORE) {
#pragma unroll
        for (int i = 0; i < 4; ++i) { const int p = tid + NT * i, row = p >> 5, ch = p & 31;
            *(u32x4*)(P.QA() + pofs(row0 + c * 64 + row, 512) + hg * 256 + ch * 8) = *(const LAS u32x4*)(lds + ATT_K0 + row * ATT_KSTR + ch * 16); } }
    __syncthreads();
}

constexpr int NSC = NCH / 4, NUNIT = BATCH * 4 * NSC;
constexpr int GA_SET = 64 * G1_QSTR * 2 + 64 * G1_ESTR + 64 * G1_VSTR;
constexpr int GA_QT = 0, GA_KT = GA_QT + 64 * G1_QSTR, GA_KE = GA_KT + 64 * G1_QSTR, GA_V = GA_KE + 64 * G1_ESTR;
constexpr int GA_ST = 2 * GA_SET, GA_STSZ = 128 * G1_QSTR, GA_TOT = GA_ST + 2 * GA_STSZ, GA_DEC = GA_TOT + 2 * 8 * 64 * 4, GA_END = GA_DEC + 2 * 256;
template <bool STORE = true> DEV void gla_a_unit(const Ptrs& P, lds_t lds, int u) {
    int tid_ = threadIdx.x; OPAQUE_V(tid_); const int tid = tid_, lane = tid & 63, w = tid >> 6, l31 = lane & 31, hi = lane >> 5;
    const int sc = u % NSC, bh = u / NSC, h = bh & 3, b = bh >> 2;
    const int dvb = w >> 1, ib = w & 1;
    const int tt = lane & 7, db = lane >> 3, tk = 8 * w + tt;
    float dstart[8];
#pragma unroll
    for (int i = 0; i < 8; ++i) dstart[i] = 1.f;
    f32x16 st;
#pragma unroll
    for (int r = 0; r < 16; ++r) st[r] = 0.f;
    u32x4 la[4], qr[4], kr[4], vreg[4][2];
    bf16_t* const pan = P.proj + (size_t)(b * (SEQ / 256) + sc) * PBE;
    const unsigned eofs = (unsigned)(tk * 256 + h * 64 + 8 * db), vofs = (unsigned)((tid >> 4) * 512 + h * 128 + (tid & 15) * 8);
#pragma unroll
    for (int j = 0; j < 4; ++j) {
        la[j] = *(const u32x4*)(pan + O_LA + eofs + j * 64 * 256);
        qr[j] = *(const u32x4*)(pan + O_QB + eofs + j * 64 * 256); kr[j] = *(const u32x4*)(pan + O_KB + eofs + j * 64 * 256);
#pragma unroll
        for (int i = 0; i < 2; ++i) vreg[j][i] = *(const u32x4*)(pan + O_VB + vofs + (j * 64 + i * 32) * 512); }
    float mk[16];
#pragma unroll
    for (int r = 0; r < 16; ++r) mk[r] = crow(r, hi) > l31 ? 0.f : 1.f;
    const int colbV = dvb * 32 + 16 * ((lane >> 4) & 1) + 4 * (lane & 3), colbK = ib * 32 + 16 * ((lane >> 4) & 1) + 4 * (lane & 3);
    const float m1 = tt >= 1 ? 1.f : 0.f, m2 = tt >= 2 ? 1.f : 0.f, m4 = tt >= 4 ? 1.f : 0.f;
    const int grp = lane & ~7;
#pragma unroll
    for (int j = 0; j < 4; ++j) {
        const size_t row0 = ((size_t)b * NCH + 4 * sc + j) * 64; const size_t item = ((size_t)b * NCH + 4 * sc + j) * 4 + h;
        const lds_t S = lds + (j & 1) * GA_SET;
        LAS float* tot = (LAS float*)(lds + GA_TOT + (j & 1) * 2048); LAS float* dec = (LAS float*)(lds + GA_DEC + (j & 1) * 256);
        float lc[8];
        { f32x4 l0, l1; unpack8(la[j], l0, l1);
#pragma unroll
          for (int i = 0; i < 4; ++i) { lc[i] = l0[i]; lc[4 + i] = l1[i]; } }
#pragma unroll
        for (int i = 0; i < 8; ++i) lc[i] = fmaf(DPP_SHR_F(lc[i], 1), m1, lc[i]);
#pragma unroll
        for (int i = 0; i < 8; ++i) lc[i] = fmaf(DPP_SHR_F(lc[i], 2), m2, lc[i]);
#pragma unroll
        for (int i = 0; i < 8; ++i) lc[i] = fmaf(DPP_SHR_F(lc[i], 4), m4, lc[i]);
        if (tt == 7) { *(LAS f32x4*)(tot + w * 64 + 8 * db) = (f32x4){lc[0], lc[1], lc[2], lc[3]}; *(LAS f32x4*)(tot + w * 64 + 8 * db + 4) = (f32x4){lc[4], lc[5], lc[6], lc[7]}; }
#pragma unroll
        for (int i = 0; i < 2; ++i) { const int pc = tid + NT * i, row = pc >> 4, ch = pc & 15; *(LAS u32x4*)(S + GA_V + row * G1_VSTR + ch * 16) = vreg[j][i]; }
        __syncthreads();
        float off1 = 0.f, tot1 = 0.f;
#pragma unroll
        for (int s = 0; s < 8; ++s) { const float x = tot[s * 64 + 8 * db + tt]; tot1 += x; off1 += (s < w) ? x : 0.f; }
        const float dtot1 = EXP2F(tot1 * LOG2E);
        f32x4 q0, q1, k0, k1; unpack8(qr[j], q0, q1); unpack8(kr[j], k0, k1);
        float qt[8], kt[8], ke[8], qd[8];
#pragma unroll
        for (int i = 0; i < 8; ++i) { const float dti = bperm_f(grp + i, dtot1), bcur = bperm_f(grp + i, off1) + lc[i], qv = i < 4 ? q0[i & 3] : q1[i & 3], kv = i < 4 ? k0[i & 3] : k1[i & 3];
            qt[i] = qv * EXP2F(bcur * LOG2E); kt[i] = kv * EXP2F(-bcur * LOG2E); ke[i] = kt[i] * dti; qd[i] = qt[i] * dstart[i]; dstart[i] *= dti; }
        *(LAS u32x4*)(S + GA_QT + tk * G1_QSTR + db * 16) = pack8((f32x4){qt[0], qt[1], qt[2], qt[3]}, (f32x4){qt[4], qt[5], qt[6], qt[7]});
        *(LAS u32x4*)(S + GA_KT + tk * G1_QSTR + db * 16) = pack8((f32x4){kt[0], kt[1], kt[2], kt[3]}, (f32x4){kt[4], kt[5], kt[6], kt[7]});
        *(LAS u32x4*)(S + GA_KE + tk * G1_ESTR + db * 16) = pack8((f32x4){ke[0], ke[1], ke[2], ke[3]}, (f32x4){ke[4], ke[5], ke[6], ke[7]});
        if (STORE) *(u32x4*)(pan + O_QB + eofs + j * 64 * 256) = pack8((f32x4){qd[0], qd[1], qd[2], qd[3]}, (f32x4){qd[4], qd[5], qd[6], qd[7]});
        if (w == 0) dec[8 * db + tt] = dtot1;
        __syncthreads();
        f32x16 oi;
#pragma unroll
        for (int r = 0; r < 16; ++r) oi[r] = 0.f;
        for (int jb = 0; jb <= ib; ++jb) {
            f32x16 att;
#pragma unroll
            for (int r = 0; r < 16; ++r) att[r] = 0.f;
#pragma unroll
            for (int ks = 0; ks < 4; ++ks) { const bf16x8 a = *(const LAS bf16x8*)(S + GA_KT + (jb * 32 + l31) * G1_QSTR + (ks * 16 + hi * 8) * 2);
                const bf16x8 bq = *(const LAS bf16x8*)(S + GA_QT + (ib * 32 + l31) * G1_QSTR + (ks * 16 + hi * 8) * 2);
                att = MFMA32(a, bq, att); }
            if (jb == ib) {
#pragma unroll
                for (int r = 0; r < 16; ++r) att[r] *= mk[r]; }
#pragma unroll
            for (int s2 = 0; s2 < 2; ++s2) { u32x4 uu;
#pragma unroll
                for (int e = 0; e < 4; ++e) uu[e] = cvtpk(att[8 * s2 + 2 * e], att[8 * s2 + 2 * e + 1]);
                const bf16x8 pf = __builtin_bit_cast(bf16x8, uu);
                const int keyb = jb * 32 + s2 * 16 + 4 * hi + ((lane & 15) >> 2);
                const s16x4 lo = TR_READ(S + GA_V + keyb * G1_VSTR + colbV * 2), h4 = TR_READ(S + GA_V + (keyb + 8) * G1_VSTR + colbV * 2);
                const bf16x8 a = {lo[0], lo[1], lo[2], lo[3], h4[0], h4[1], h4[2], h4[3]};
                oi = MFMA32(a, pf, oi); }
        }
        if (j > 0) {
            const lds_t STp = lds + GA_ST + ((j - 1) & 1) * GA_STSZ;
#pragma unroll
            for (int ks = 0; ks < 4; ++ks) { const bf16x8 a = *(const LAS bf16x8*)(STp + (dvb * 32 + l31) * G1_QSTR + (ks * 16 + hi * 8) * 2);
                const bf16x8 bq = *(const LAS bf16x8*)(S + GA_QT + (ib * 32 + l31) * G1_QSTR + (ks * 16 + hi * 8) * 2);
                oi = MFMA32(a, bq, oi); } }
        { bf16_t* op = (bf16_t*)P.OI + (item * 8 + w) * 16 * 64 + lane * 8;
#pragma unroll
          for (int g8 = 0; g8 < 2; ++g8) *(u32x4*)(op + g8 * 512) = pack8((f32x4){oi[8 * g8], oi[8 * g8 + 1], oi[8 * g8 + 2], oi[8 * g8 + 3]}, (f32x4){oi[8 * g8 + 4], oi[8 * g8 + 5], oi[8 * g8 + 6], oi[8 * g8 + 7]}); }
        f32x16 ds;
#pragma unroll
        for (int r = 0; r < 16; ++r) ds[r] = 0.f;
#pragma unroll
        for (int s = 0; s < 4; ++s) { const int tb = s * 16 + 4 * hi + ((lane & 15) >> 2);
            const s16x4 alo = TR_READ(S + GA_V + tb * G1_VSTR + colbV * 2), ahi = TR_READ(S + GA_V + (tb + 8) * G1_VSTR + colbV * 2);
            const s16x4 blo = TR_READ(S + GA_KE + tb * G1_ESTR + colbK * 2), bhi = TR_READ(S + GA_KE + (tb + 8) * G1_ESTR + colbK * 2);
            const bf16x8 a = {alo[0], alo[1], alo[2], alo[3], ahi[0], ahi[1], ahi[2], ahi[3]}, bb = {blo[0], blo[1], blo[2], blo[3], bhi[0], bhi[1], bhi[2], bhi[3]};
            ds = MFMA32(a, bb, ds); }
        const float dl = dec[ib * 32 + l31];
#pragma unroll
        for (int r = 0; r < 16; ++r) st[r] = fmaf(dl, st[r], ds[r]);
        {
            const lds_t STn = lds + GA_ST + (j & 1) * GA_STSZ;
#pragma unroll
            for (int r = 0; r < 16; r += 2) { const unsigned pk = cvtpk(st[r], st[r + 1]);
                *(LAS bf16_t*)(STn + (dvb * 32 + crow(r, hi)) * G1_QSTR + (ib * 32 + l31) * 2) = (bf16_t)(pk & 0xffffu); *(LAS bf16_t*)(STn + (dvb * 32 + crow(r, hi) + 1) * G1_QSTR + (ib * 32 + l31) * 2) = (bf16_t)(pk >> 16); } }
    }
    __syncthreads();
    { const lds_t ST3 = lds + GA_ST + GA_STSZ;
#pragma unroll
      for (int i = 0; i < 2; ++i) { const int pc = tid + NT * i, row = pc >> 3, ch = pc & 7; *(u32x4*)(P.DSS + (size_t)u * 8192 + row * 64 + ch * 8) = *(const LAS u32x4*)(ST3 + row * G1_QSTR + ch * 16); } }
    if (tk == 0) { float* dtp = P.DT + (size_t)u * 64 + 8 * db; *(f32x4*)dtp = (f32x4){dstart[0], dstart[1], dstart[2], dstart[3]}; *(f32x4*)(dtp + 4) = (f32x4){dstart[4], dstart[5], dstart[6], dstart[7]}; }
    __syncthreads();
}

constexpr int GB_YSTR = 272;
constexpr int GB_ST = 0, GB_RED = 128 * G1_QSTR, GB_DT = GB_RED + 2048, GB_Q = GB_DT + 8 * 64 * 4, GB_QSZ = 64 * G1_QSTR, GB_TSZ = 64 * GB_YSTR, GB_RB = GB_Q + 2 * GB_QSZ, GB_Y = GB_RB + 2 * GB_TSZ, GB_END = GB_Y + 2 * GB_TSZ;
DEV void gla_b_unit(const Ptrs& P, int layer, lds_t lds, int u) {
    int tid_ = threadIdx.x; OPAQUE_V(tid_); const int tid = tid_, lane = tid & 63, w = tid >> 6, l31 = lane & 31, hi = lane >> 5;
    const int sc = u % NSC, bh = u / NSC, h = bh & 3, b = bh >> 2, u0 = u - sc;
    const int dvb = w >> 1, ib = w & 1;
    u32x4 on[2], qn, rbn[2];
    bf16_t* const pan = P.proj + (size_t)(b * (SEQ / 256) + sc) * PBE;
    const unsigned vofs = (unsigned)((tid >> 4) * 512 + h * 128 + (tid & 15) * 8), qofs = (unsigned)((tid >> 3) * 256 + h * 64 + (tid & 7) * 8);
#define GB_LOAD(j) do { const size_t item_ = ((size_t)b * NCH + 4 * sc + (j)) * 4 + h; const bf16_t* op = (const bf16_t*)P.OI + (item_ * 8 + w) * 16 * 64 + lane * 8; \
        _Pragma("unroll") for (int g8 = 0; g8 < 2; ++g8) on[g8] = *(const u32x4*)(op + g8 * 512); \
        _Pragma("unroll") for (int i = 0; i < 2; ++i) rbn[i] = *(const u32x4*)(pan + O_RB + vofs + ((j) * 64 + i * 32) * 512); \
        if (sc > 0) qn = *(const u32x4*)(pan + O_QB + qofs + (j) * 64 * 256); } while (0)
    GB_LOAD(0);
    f32x4 gg[4];
#pragma unroll
    for (int g4 = 0; g4 < 4; ++g4) gg[g4] = *(const f32x4*)(P.gng + layer * 512 + h * 128 + dvb * 32 + 8 * g4 + 4 * hi);
    if (sc > 0) {
        LAS float* dts = (LAS float*)(lds + GB_DT);
        bf16x8 vv[2][NSC - 1];
#pragma unroll
        for (int pp = 0; pp < 2; ++pp)
#pragma unroll
            for (int s = 0; s < NSC - 1; ++s) { const int ss = s < sc ? s : sc - 1; vv[pp][s] = *(const bf16x8*)(P.DSS + (size_t)(u0 + ss) * 8192 + (pp * NT + tid) * 8); }
        if (tid < (NSC - 1) * 64) { const int s = tid >> 6, ss = s < sc ? s : sc - 1; dts[tid] = P.DT[(size_t)(u0 + ss) * 64 + (tid & 63)]; }
        __syncthreads();
#pragma unroll
        for (int pp = 0; pp < 2; ++pp) { const int e8 = (pp * NT + tid) * 8, dkk = e8 & 63; f32x4 sa = {0.f, 0.f, 0.f, 0.f}, sb = {0.f, 0.f, 0.f, 0.f};
#pragma unroll
            for (int s = 0; s < NSC - 1; ++s) if (s < sc) { const f32x4 da = *(const LAS f32x4*)(dts + s * 64 + dkk), db = *(const LAS f32x4*)(dts + s * 64 + dkk + 4); f32x4 va, vb; unpack8(__builtin_bit_cast(u32x4, vv[pp][s]), va, vb);
                sa = da * sa + va; sb = db * sb + vb; }
            *(LAS u32x4*)(lds + GB_ST + (e8 >> 6) * G1_QSTR + dkk * 2) = pack8(sa, sb); }
    }
    LAS float* red = (LAS float*)(lds + GB_RED);
#define GB_YSTORE(jj) do { const lds_t ys_ = lds + GB_Y + ((jj) & 1) * GB_TSZ; _Pragma("unroll") for (int i = 0; i < 2; ++i) { const int pc = tid + NT * i; \
        *(u32x4*)(pan + O_VB + vofs + ((jj) * 64 + i * 32) * 512) = *(const LAS u32x4*)(ys_ + (pc >> 4) * GB_YSTR + (pc & 15) * 16); } } while (0)
#pragma unroll 1
    for (int j = 0; j < 4; ++j) {
        const lds_t Qt = lds + GB_Q + (j & 1) * GB_QSZ, Rt = lds + GB_RB + (j & 1) * GB_TSZ, Yt = lds + GB_Y + (j & 1) * GB_TSZ;
        f32x16 o;
#pragma unroll
        for (int g8 = 0; g8 < 2; ++g8) { f32x4 a, c; unpack8(on[g8], a, c);
#pragma unroll
            for (int e = 0; e < 4; ++e) { o[8 * g8 + e] = a[e]; o[8 * g8 + 4 + e] = c[e]; } }
#pragma unroll
        for (int i = 0; i < 2; ++i) { const int pc = tid + NT * i; *(LAS u32x4*)(Rt + (pc >> 4) * GB_YSTR + (pc & 15) * 16) = rbn[i]; }
        if (sc > 0) *(LAS u32x4*)(Qt + (tid >> 3) * G1_QSTR + (tid & 7) * 16) = qn;
        __syncthreads();
        if (j > 0) GB_YSTORE(j - 1);
        if (j < 3) GB_LOAD(j + 1);
        if (sc > 0) {
#pragma unroll
            for (int ks = 0; ks < 4; ++ks) { const bf16x8 a = *(const LAS bf16x8*)(lds + GB_ST + (dvb * 32 + l31) * G1_QSTR + (ks * 16 + hi * 8) * 2);
                const bf16x8 bq = *(const LAS bf16x8*)(Qt + (ib * 32 + l31) * G1_QSTR + (ks * 16 + hi * 8) * 2);
                o = MFMA32(a, bq, o); } }
        float ss = 0.f;
#pragma unroll
        for (int r = 0; r < 16; ++r) ss += o[r] * o[r];
        ss += SHFL_XOR(ss, 32);
        if (hi == 0) red[(j & 1) * 256 + w * 32 + l31] = ss;
        __syncthreads();
        const LAS float* rr = red + (j & 1) * 256;
        const float tot = (rr[ib * 32 + l31] + rr[(2 + ib) * 32 + l31]) + (rr[(4 + ib) * 32 + l31] + rr[(6 + ib) * 32 + l31]);
        const float rs = RSQF(tot * (1.0f / 128.f) + EPS);
#pragma unroll
        for (int g4 = 0; g4 < 4; ++g4) { const int dv0 = dvb * 32 + 8 * g4 + 4 * hi; const f32x4 g = gg[g4]; const int lo = (ib * 32 + l31) * GB_YSTR + dv0 * 2;
            const u32x2 rb = *(const LAS u32x2*)(Rt + lo);
            u32x2 ov; ov[0] = cvtpk(o[4 * g4] * rs * g[0] * bflo(rb[0]), o[4 * g4 + 1] * rs * g[1] * bfhi(rb[0])); ov[1] = cvtpk(o[4 * g4 + 2] * rs * g[2] * bflo(rb[1]), o[4 * g4 + 3] * rs * g[3] * bfhi(rb[1]));
            *(LAS u32x2*)(Yt + lo) = ov; }
    }
    __syncthreads();
    GB_YSTORE(3);
#undef GB_YSTORE
#undef GB_LOAD
    __syncthreads();
}
namespace pg8 {
#define PG8_LAS __attribute__((address_space(3)))
typedef unsigned short bf16_t;
typedef short bf16x8 __attribute__((ext_vector_type(8)));
typedef float f32x4 __attribute__((ext_vector_type(4)));
typedef unsigned u32x4 __attribute__((ext_vector_type(4)));
constexpr int BM = 256, BK = 64, HALF = 128, HTB = HALF * BK * 2  , STAGE_BYTES = 8 * HTB, NXCD = 8, WGM = 8;

__host__ __device__ __forceinline__ int lds_byte(int r, int c) { const int st = (r >> 4) * 2 + (c >> 5), rr = r & 15, cc = c & 31, ob = rr * 64 + cc * 2; return st * 1024 + (ob ^ (((ob >> 9) & 1) << 5)); }
__host__ __device__ __forceinline__ void stage_rc(int b, int& R, int& C) { const int st = b / 1024, sb = b % 1024, swz = sb ^ (((sb >> 9) & 1) << 5); R = (st >> 1) * 16 + swz / 64; C = (st & 1) * 32 + (swz % 64) / 2; }
__host__ __device__ __forceinline__ int perm32(int rho) { const int n = rho >> 4, i = rho & 15; return 8 * (i >> 2) + 4 * n + (i & 3); }

struct Unit { int pm, pn; };
struct Gemm { const bf16_t* A; const bf16_t* Bt; int M, N, K, lda, ldb; size_t a_tile_bytes; int amod; size_t ahi_bytes; };

struct StaticOrder {
    int nM, nN, nwg, G, c;
    __host__ __device__ void init(int M, int N, int G_, int c_) { nM = M / BM; nN = N / BM; nwg = nM * nN; G = G_; c = c_; }
    __host__ __device__ bool next(int i, Unit& u) const {
        const long L = (long)i * G + c; if (L >= nwg) return false;
        int wgid = (int)L; { const int q = nwg / NXCD, r = nwg % NXCD, xcd = wgid % NXCD, off = wgid / NXCD; wgid = (xcd < r ? xcd * (q + 1) : r * (q + 1) + (xcd - r) * q) + off; }
        const int nig = WGM * nN, gid = wgid / nig, fm = gid * WGM, gsz = (nM - fm) < WGM ? (nM - fm) : WGM;
        u.pm = fm + ((wgid % nig) % gsz); u.pn = (wgid % nig) / gsz; return true;
    }
    __device__ __forceinline__ void a_ready(const Unit&) const {}
    __device__ __forceinline__ void done(const Unit&) const {}
};

template <class Epi, class Sched, bool ALIGN_EPI = false, bool SP2 = false>
__device__ __forceinline__ void gemm_phase(PG8_LAS unsigned char* lds, const Gemm g, const Sched& S, const Epi& E) {
    int tid_ = threadIdx.x; asm volatile("" : "+v"(tid_));
    const int tid = tid_, wid = __builtin_amdgcn_readfirstlane(tid >> 6), lane = tid & 63, wr = wid >> 2, wc = wid & 3, fr = lane & 15, fq = lane >> 4;
    const int K = g.K, nt = K / BK;
    unsigned voffA[2], voffB[2];
#pragma unroll
    for (int i = 0; i < 2; ++i) { int R, C; stage_rc(tid * 16 + i * 8192, R, C); const int Rb = Epi::PERM ? ((R & ~31) + perm32(R & 31)) : R;
        voffA[i] = (unsigned)(R * g.lda + C) * 2u; voffB[i] = (unsigned)(Rb * g.ldb + C) * 2u; }
    const size_t kstep = (size_t)(BK * 2);
    const size_t hstepA = (size_t)HALF * g.lda * 2, hstepB = (size_t)HALF * g.ldb * 2;
    const size_t tstepB = 2 * hstepB;
#define PG8_AOF(pm_) ((const char*)g.A + (size_t)((pm_) % g.amod) * g.a_tile_bytes + (size_t)((pm_) / g.amod) * g.ahi_bytes)
    const unsigned ldsw = (unsigned)wid * 1024u;
    const int aoff = lds_byte(wr * 64 + fr, fq * 8), boff = lds_byte(wc * 32 + fr, fq * 8);
#define PG8_SA(b, h) (((b) * 2 + (h)) * HTB)
#define PG8_SB(b, h) ((4 + (b) * 2 + (h)) * HTB)
#define PG8_STAGE(bufoff, gbase, voff) do { _Pragma("unroll") for (int _i = 0; _i < 2; ++_i) \
        __builtin_amdgcn_global_load_lds((const unsigned*)((const char*)(gbase) + (voff)[_i]), (PG8_LAS unsigned*)(lds + (bufoff) + ldsw + _i * 8192), 16, 0, 0); } while (0)
#define PG8_LDA(dst, b, h) do { _Pragma("unroll") for (int m = 0; m < 4; ++m) _Pragma("unroll") for (int k = 0; k < 2; ++k) dst[m][k] = *(const PG8_LAS bf16x8*)(lds + PG8_SA(b, h) + aoff + m * 2048 + k * 1024); } while (0)
#define PG8_LDB(dst, b, h) do { _Pragma("unroll") for (int n = 0; n < 2; ++n) _Pragma("unroll") for (int k = 0; k < 2; ++k) dst[n][k] = *(const PG8_LAS bf16x8*)(lds + PG8_SB(b, h) + boff + n * 2048 + k * 1024); } while (0)
#define PG8_MMA(ai, bj, At, Bt) do { __builtin_amdgcn_s_setprio(1); _Pragma("unroll") for (int m = 0; m < 4; ++m) _Pragma("unroll") for (int n = 0; n < 2; ++n) _Pragma("unroll") for (int k = 0; k < 2; ++k) \
        acc[ai][bj][m][n] = __builtin_amdgcn_mfma_f32_16x16x32_bf16(Bt[n][k], At[m][k], acc[ai][bj][m][n], 0, 0, 0); __builtin_amdgcn_s_setprio(0); } while (0)
#define PG8_WAIT_V(n) asm volatile("s_waitcnt vmcnt(" #n ")" ::: "memory")
#define PG8_WAIT_L(n) asm volatile("s_waitcnt lgkmcnt(" #n ")" ::: "memory")
#define PG8_BAR __builtin_amdgcn_s_barrier()
#define PG8_SCHED __builtin_amdgcn_sched_barrier(0)
    Unit cur, nxt; int ui = 0;
    if (!S.next(0, cur)) return;
    f32x4 acc[2][2][4][2];
#pragma unroll
    for (int a = 0; a < 2; ++a)
#pragma unroll
        for (int b = 0; b < 2; ++b)
#pragma unroll
            for (int m = 0; m < 4; ++m)
#pragma unroll
                for (int n = 0; n < 2; ++n) acc[a][b][m][n] = (f32x4){0.f, 0.f, 0.f, 0.f};
    bf16x8 At[4][2], B0[2][2], B1[2][2];
    const char* cA = PG8_AOF(cur.pm); const char* cB = (const char*)g.Bt + (size_t)cur.pn * tstepB;
    S.a_ready(cur);
    if constexpr (SP2) {
        PG8_STAGE(PG8_SB(0, 0), cB, voffB); PG8_STAGE(PG8_SB(0, 1), cB + hstepB, voffB); PG8_STAGE(PG8_SA(0, 0), cA, voffA); PG8_STAGE(PG8_SA(0, 1), cA + hstepA, voffA);
        if (wr == 1) PG8_BAR;
        PG8_WAIT_V(2); PG8_BAR;
        PG8_STAGE(PG8_SB(1, 0), cB + kstep, voffB); PG8_STAGE(PG8_SA(1, 0), cA + kstep, voffA); PG8_STAGE(PG8_SB(1, 1), cB + hstepB + kstep, voffB);
        PG8_WAIT_V(6); PG8_BAR;
    } else {
        PG8_STAGE(PG8_SB(0, 0), cB, voffB); PG8_STAGE(PG8_SA(0, 0), cA, voffA); PG8_STAGE(PG8_SB(0, 1), cB + hstepB, voffB); PG8_STAGE(PG8_SA(0, 1), cA + hstepA, voffA);
        if (wr == 1) PG8_BAR;
        PG8_WAIT_V(4); PG8_BAR;
        PG8_STAGE(PG8_SB(1, 0), cB + kstep, voffB); PG8_STAGE(PG8_SA(1, 0), cA + kstep, voffA); PG8_STAGE(PG8_SB(1, 1), cB + hstepB + kstep, voffB);
        PG8_WAIT_V(6); PG8_BAR;
    }
    for (;;) {
        const bool has_next = S.next(ui + 1, nxt);
        const char* nA = has_next ? PG8_AOF(nxt.pm) : cA; const char* nB = has_next ? (const char*)g.Bt + (size_t)nxt.pn * tstepB : cB;
        for (int t = 0; t < nt; t += 2) {
            const bool last = (t == nt - 2);
            const char* a1 = cA + (size_t)(t + 1) * kstep;
            const char* a2 = last ? nA : cA + (size_t)(t + 2) * kstep; const char* b2 = last ? nB : cB + (size_t)(t + 2) * kstep;
            const char* a3 = a2 + kstep; const char* b3 = b2 + kstep;
            if (last && has_next) S.a_ready(nxt);
            if constexpr (SP2) {
            PG8_LDB(B0, 0, 0); PG8_LDB(B1, 0, 1); PG8_SCHED; PG8_LDA(At, 0, 0); PG8_STAGE(PG8_SA(1, 1), a1 + hstepA, voffA);
            PG8_WAIT_V(8); PG8_WAIT_L(0); PG8_BAR; PG8_MMA(0, 0, At, B0); PG8_MMA(0, 1, At, B1); PG8_BAR; PG8_SCHED;
            PG8_LDA(At, 0, 1); PG8_STAGE(PG8_SB(0, 0), b2, voffB); PG8_STAGE(PG8_SB(0, 1), b2 + hstepB, voffB); PG8_STAGE(PG8_SA(0, 0), a2, voffA);
            PG8_WAIT_V(8); PG8_WAIT_L(0); PG8_BAR; PG8_MMA(1, 0, At, B0); PG8_MMA(1, 1, At, B1); PG8_BAR; PG8_SCHED;
            PG8_LDB(B0, 1, 0); PG8_LDB(B1, 1, 1); PG8_SCHED; PG8_LDA(At, 1, 0); PG8_STAGE(PG8_SA(0, 1), a2 + hstepA, voffA);
            PG8_WAIT_V(8); PG8_WAIT_L(0); PG8_BAR; PG8_MMA(0, 0, At, B0); PG8_MMA(0, 1, At, B1); PG8_BAR; PG8_SCHED;
            PG8_LDA(At, 1, 1); PG8_STAGE(PG8_SB(1, 0), b3, voffB); PG8_STAGE(PG8_SB(1, 1), b3 + hstepB, voffB); PG8_STAGE(PG8_SA(1, 0), a3, voffA);
            PG8_WAIT_V(8); PG8_WAIT_L(0); PG8_BAR; PG8_MMA(1, 0, At, B0); PG8_MMA(1, 1, At, B1); PG8_BAR; PG8_SCHED;
            } else {
            PG8_LDB(B0, 0, 0); PG8_SCHED; PG8_LDA(At, 0, 0); PG8_STAGE(PG8_SA(1, 1), a1 + hstepA, voffA);
            PG8_WAIT_L(8); PG8_BAR; PG8_WAIT_L(0); PG8_MMA(0, 0, At, B0); PG8_BAR; PG8_SCHED;
            PG8_LDB(B1, 0, 1); PG8_STAGE(PG8_SB(0, 0), b2, voffB);
            PG8_BAR; PG8_WAIT_L(0); PG8_MMA(0, 1, At, B1); PG8_BAR;
            PG8_LDA(At, 0, 1); PG8_STAGE(PG8_SA(0, 0), a2, voffA);
            PG8_BAR; PG8_WAIT_L(0); PG8_MMA(1, 0, At, B0); PG8_BAR; PG8_SCHED;
            PG8_STAGE(PG8_SB(0, 1), b2 + hstepB, voffB);
            PG8_WAIT_V(6); PG8_BAR; PG8_MMA(1, 1, At, B1); PG8_BAR;
            PG8_LDB(B0, 1, 0); PG8_SCHED; PG8_LDA(At, 1, 0); PG8_STAGE(PG8_SA(0, 1), a2 + hstepA, voffA);
            PG8_WAIT_L(8); PG8_BAR; PG8_WAIT_L(0); PG8_MMA(0, 0, At, B0); PG8_BAR; PG8_SCHED;
            PG8_LDB(B1, 1, 1); PG8_STAGE(PG8_SB(1, 0), b3, voffB);
            PG8_BAR; PG8_WAIT_L(0); PG8_MMA(0, 1, At, B1); PG8_BAR;
            PG8_LDA(At, 1, 1); PG8_STAGE(PG8_SA(1, 0), a3, voffA);
            PG8_BAR; PG8_WAIT_L(0); PG8_MMA(1, 0, At, B0); PG8_BAR; PG8_SCHED;
            PG8_STAGE(PG8_SB(1, 1), b3 + hstepB, voffB);
            PG8_WAIT_V(6); PG8_BAR; PG8_MMA(1, 1, At, B1); PG8_BAR;
            }
        }
        if constexpr (ALIGN_EPI) { if (wr == 0) PG8_BAR; }
        if constexpr (!Epi::AFTER_DRAIN) { E(acc, cur, wr, wc, fr, fq); S.done(cur); }
        if (!has_next) break;
#pragma unroll
        for (int a = 0; a < 2; ++a)
#pragma unroll
            for (int b = 0; b < 2; ++b)
#pragma unroll
                for (int m = 0; m < 4; ++m)
#pragma unroll
                    for (int n = 0; n < 2; ++n) acc[a][b][m][n] = (f32x4){0.f, 0.f, 0.f, 0.f};
        cur = nxt; cA = nA; cB = nB; ++ui;
        if constexpr (ALIGN_EPI) { if (wr == 1) PG8_BAR; }
    }
    PG8_WAIT_V(0);
    if constexpr (!ALIGN_EPI) { if (wr == 0) PG8_BAR; }
    PG8_BAR;
    if constexpr (Epi::AFTER_DRAIN) { E.fused(acc, cur, wr, wc, fr, fq, lds, wid, lane); S.done(cur); }
#undef PG8_AOF
#undef PG8_SA
#undef PG8_SB
#undef PG8_STAGE
#undef PG8_LDA
#undef PG8_LDB
#undef PG8_MMA
#undef PG8_WAIT_V
#undef PG8_WAIT_L
#undef PG8_BAR
#undef PG8_SCHED
}
}
#ifdef EMU
namespace pg8 { struct Unit { int pm, pn; }; constexpr int BM = 256, HALF = 128; }
#endif
typedef f32x4 acc_t[2][2][4][2];

struct EpiIn {
    static constexpr bool PERM = true, AFTER_DRAIN = false;
    Ptrs P; const unsigned long long* ssq; const LAS float* rs_lds; int pm_lds;
    DEV void operator()(const acc_t& acc, const pg8::Unit& u, int wr, int wc, int fr_, int fq_) const {
        int fr = fr_, fq = fq_; OPAQUE_V(fr); OPAQUE_V(fq);
        const int pn = u.pn; bf16_t* base; int ld, c0, act = 0;
        if (pn < 2) { base = P.QA(); ld = 512; c0 = pn * 256; } else if (pn < 4) { base = P.KA(); ld = 512; c0 = (pn - 2) * 256; } else if (pn < 6) { base = P.VA(); ld = 512; c0 = (pn - 4) * 256; }
        else if (pn == 6) { base = P.QB(); ld = 256; c0 = 0; } else if (pn == 7) { base = P.KB(); ld = 256; c0 = 0; } else if (pn < 10) { base = P.VB(); ld = 512; c0 = (pn - 8) * 256; }
        else if (pn < 12) { base = P.RB(); ld = 512; c0 = (pn - 10) * 256; act = 1; }
        else if (pn < 16) { base = P.GA(); ld = 1024; c0 = (pn - 12) * 256; act = 2; } else { base = P.GB(); ld = 1024; c0 = (pn - 16) * 256; act = 2; }
        base += (size_t)u.pm * PBE;
        const int rowb = wr * 64 + fr, colb = c0 + wc * 32 + 8 * fq;
        float rs[2][4];
        const float bad = (u.pm == pm_lds) ? 1.0f : __builtin_nanf("");
#pragma unroll
        for (int ai = 0; ai < 2; ++ai)
#pragma unroll
            for (int m = 0; m < 4; ++m) rs[ai][m] = rs_lds[wr * 64 + fr + ai * 128 + m * 16] * bad;
        if (act == 0) body<0>(acc, rs, base, ld, rowb, colb); else if (act == 1) body<1>(acc, rs, base, ld, rowb, colb); else body<2>(acc, rs, base, ld, rowb, colb);
    }
    template <int ACT> DEV static void body(const acc_t& acc, const float (&rs)[2][4], bf16_t* base, int ld, int rowb, int colb) {
        const int lane = (rowb & 15) + 16 * (((colb & 31)) >> 3), r2 = (rowb & ~15) + (lane >> 2), c2 = (colb & ~31) + 8 * (lane & 3);
#pragma unroll
        for (int ai = 0; ai < 2; ++ai)
#pragma unroll
            for (int m = 0; m < 4; ++m) { bf16_t* rowp = base + (size_t)(r2 + ai * 128 + m * 16) * ld + c2;
#pragma unroll
                for (int bj = 0; bj < 2; ++bj) { const float sc_ = (ACT == 2) ? rs[ai][m] * -LOG2E : rs[ai][m];
                    f32x4 v0 = acc[ai][bj][m][0] * sc_, v1 = acc[ai][bj][m][1] * sc_;
                    if (ACT == 1) {
#pragma unroll
                        for (int e = 0; e < 4; ++e) { v0[e] = v0[e] * sigmoidf_(v0[e]); v1[e] = v1[e] * sigmoidf_(v1[e]); } }
                    else if (ACT == 2) {
#pragma unroll
                        for (int e = 0; e < 4; ++e) { v0[e] = RCPF(1.0f + EXP2F(v0[e])); v1[e] = RCPF(1.0f + EXP2F(v1[e])); } }
                    ST16_WT(rowp + bj * 128, quad_rows(pack8(v0, v1), lane)); }
                SCHED_FENCE(); }
    }
};
struct EpiMerge {
    static constexpr bool PERM = true, AFTER_DRAIN = false;
    Ptrs P;
    DEV void operator()(const acc_t& acc, const pg8::Unit& u, int wr, int wc, int fr_, int fq_) const {
        int fr = fr_, fq = fq_; OPAQUE_V(fr); OPAQUE_V(fq);
        const int br = u.pm >= (M / 256) ? 1 : 0, pm = u.pm - br * (M / 256), pn = u.pn - br * 4;
        const bf16_t* gate = br ? P.GB() : P.GA();
        const int lane = fr + 16 * fq, rowb = wr * 64 + (lane >> 2), colb = pn * 256 + wc * 32 + 8 * (lane & 3);
        const size_t pb = (size_t)pm * PBE;
        if (br == 0) body<0>(acc, gate, P.T(), P.MERGED(), pb, rowb, colb, lane); else body<1>(acc, gate, P.T(), P.MERGED(), pb, rowb, colb, lane);
    }
    template <int BR> DEV static void body(const acc_t& acc, const bf16_t* gate, bf16_t* T, bf16_t* MG, size_t pb, int rowb, int colb, int lane) {
#pragma unroll
        for (int ai = 0; ai < 2; ++ai) {
            u32x4 gv[4][2], tv[4][2];
#pragma unroll
            for (int m = 0; m < 4; ++m) { const size_t off = pb + (size_t)(rowb + ai * 128 + m * 16) * 1024 + colb;
#pragma unroll
                for (int bj = 0; bj < 2; ++bj) { gv[m][bj] = *(const u32x4*)(gate + off + bj * 128); if (BR) tv[m][bj] = *(const u32x4*)(T + off + bj * 128); } }
#pragma unroll
            for (int m = 0; m < 4; ++m) { const size_t off = pb + (size_t)(rowb + ai * 128 + m * 16) * 1024 + colb;
#pragma unroll
                for (int bj = 0; bj < 2; ++bj) { f32x4 g0, g1; unpack8(gv[m][bj], g0, g1);
                    f32x4 v0 = quad_rows_f(acc[ai][bj][m][0], lane) * g0, v1 = quad_rows_f(acc[ai][bj][m][1], lane) * g1;
                    if (BR == 0) *(u32x4*)(T + off + bj * 128) = pack8(v0, v1);
                    else { f32x4 t0, t1; unpack8(tv[m][bj], t0, t1); ST16_WT(MG + off + bj * 128, pack8(v0 + t0, v1 + t1)); } } }
            SCHED_FENCE();
        }
    }
};
template <bool DRY = false> struct EpiResT {
    static constexpr bool PERM = true, AFTER_DRAIN = false;
    Ptrs P; unsigned long long* ssq_out;
    DEV void operator()(const acc_t& acc, const pg8::Unit& u, int wr, int wc, int fr_, int fq_) const {
        int fr = fr_, fq = fq_; OPAQUE_V(fr); OPAQUE_V(fq);
        const int lane = fr + 16 * fq, rowb = u.pm * 256 + wr * 64 + (lane >> 2), colb = u.pn * 256 + wc * 32 + 8 * (lane & 3);
#pragma unroll
        for (int ai = 0; ai < 2; ++ai) {
            u32x4 xv[4][2];
#pragma unroll
            for (int m = 0; m < 4; ++m)
#pragma unroll
                for (int bj = 0; bj < 2; ++bj) xv[m][bj] = *(const u32x4*)(P.XN + (size_t)(rowb + ai * 128 + m * 16) * DM + colb + bj * 128);
#pragma unroll
            for (int m = 0; m < 4; ++m) { const int row = rowb + ai * 128 + m * 16; const size_t off = (size_t)row * DM + colb; float s = 0.f;
#pragma unroll
                for (int bj = 0; bj < 2; ++bj) { bf16_t* xp = P.XN + off + bj * 128; f32x4 r0, r1; unpack8(xv[m][bj], r0, r1);
                    r0 += quad_rows_f(acc[ai][bj][m][0], lane); r1 += quad_rows_f(acc[ai][bj][m][1], lane); if (!DRY) ST16_WT(xp, pack8(r0, r1)); else if (r0[0] == 1.2345e30f) ST16_WT(xp, pack8(r0, r1));
                    s += ((r0[0] * r0[0] + r0[1] * r0[1]) + (r0[2] * r0[2] + r0[3] * r0[3])) + ((r1[0] * r1[0] + r1[1] * r1[1]) + (r1[2] * r1[2] + r1[3] * r1[3])); }
                s += SHFL_XOR(s, 1); s += SHFL_XOR(s, 2);
                if ((lane & 3) == 0 && (!DRY || s == 1.2345e30f)) ATOMIC_ADD_U64(ssq_out + row, (unsigned long long)(s * SSQ_SCALE)); }
        }
    }
};
typedef EpiResT<false> EpiRes;
struct EpiUp {
    static constexpr bool PERM = true, AFTER_DRAIN = false;
    Ptrs P; const unsigned long long* ssq; const LAS float* rs_lds; int pm_lds;
    DEV void operator()(const acc_t& acc, const pg8::Unit& u, int wr, int wc, int fr_, int fq_) const {
        int fr = fr_, fq = fq_; OPAQUE_V(fr); OPAQUE_V(fq);
        const int rowb = u.pm * 256 + wr * 64 + fr, colb = u.pn * 256 + wc * 32 + 8 * fq;
        float rs[2][4];
        const float bad = (u.pm == pm_lds) ? 1.0f : __builtin_nanf("");
#pragma unroll
        for (int ai = 0; ai < 2; ++ai)
#pragma unroll
            for (int m = 0; m < 4; ++m) rs[ai][m] = rs_lds[wr * 64 + fr + ai * 128 + m * 16] * bad;
        const int lane = fr + 16 * fq, r2 = wr * 64 + (lane >> 2), c2 = u.pn * 256 + wc * 32 + 8 * (lane & 3);
#pragma unroll
        for (int ai = 0; ai < 2; ++ai)
#pragma unroll
            for (int m = 0; m < 4; ++m) { bf16_t* rowp = P.HID() + (size_t)u.pm * PBE + (size_t)(r2 + ai * 128 + m * 16) * LDH + c2;
#pragma unroll
                for (int bj = 0; bj < 2; ++bj) { f32x4 v0 = acc[ai][bj][m][0] * rs[ai][m], v1 = acc[ai][bj][m][1] * rs[ai][m];
#pragma unroll
                    for (int e = 0; e < 4; ++e) { v0[e] = fmaxf(v0[e], 0.f); v0[e] *= v0[e]; v1[e] = fmaxf(v1[e], 0.f); v1[e] *= v1[e]; }
                    ST16_WT(rowp + bj * 128, quad_rows(pack8(v0, v1), lane)); } }
    }
};
#define XB_TMO      128
#define XB_XCNT(j)  (256  + 64 * (j))
#define XB_XSUB(j)  (1280 + 64 * (j))
#define XB_XGEN(j)  (2304 + 64 * (j))
#define XB_TOP      3328
#define XB_TOPGEN   3392
#define XCD_BAR_WORDS 3456
#define XB_SPIN_CAP (1u << 18)

__device__ __forceinline__ unsigned xb_ld(unsigned* p)              { return __hip_atomic_load(p, __ATOMIC_RELAXED, __HIP_MEMORY_SCOPE_AGENT); }
__device__ __forceinline__ unsigned xb_add(unsigned* p, unsigned v) { return __hip_atomic_fetch_add(p, v, __ATOMIC_RELAXED, __HIP_MEMORY_SCOPE_AGENT); }
__device__ __forceinline__ unsigned xb_xcc_id() { return (unsigned)__builtin_amdgcn_s_getreg((3 << 11) | 20) & 0xFu; }
#define XB_SPIN(cond, bar) do { unsigned _sp = 0; while (cond) { __builtin_amdgcn_s_sleep(1); \
    if ((++_sp & 255u) == 0u) { if (xb_ld(&(bar)[XB_TMO])) break; if (_sp > XB_SPIN_CAP) { atomicAdd(&(bar)[XB_TMO], 1u); break; } } } } while (0)

struct XcdBarrier {
    unsigned* bar; unsigned x;
    volatile LAS unsigned* st;
};

__device__ __forceinline__ XcdBarrier xcd_barrier_post(unsigned* bar, volatile LAS unsigned* st) {
    XcdBarrier b; b.bar = bar; b.x = xb_xcc_id(); b.st = st;
    if (threadIdx.x == 0) (void)xb_add(&bar[XB_XCNT(b.x)], 1u);
    return b;
}
__device__ __forceinline__ void xcd_barrier_complete(unsigned* bar, unsigned x, unsigned& nloc, unsigned& nx) {
    const unsigned G = gridDim.x * gridDim.y * gridDim.z;
    unsigned sum, cnt, mine, sp = 0u;
    for (;;) {
        sum = 0u; cnt = 0u; mine = 0u;
#pragma unroll
        for (unsigned j = 0; j < 16; ++j) { const unsigned c = xb_ld(&bar[XB_XCNT(j)]); sum += c; cnt += (c > 0u) ? 1u : 0u; mine = (j == x) ? c : mine; }
        if (sum == G) break;
        __builtin_amdgcn_s_sleep(1);
        if ((++sp & 255u) == 0u) { if (xb_ld(&bar[XB_TMO])) break; if (sp > XB_SPIN_CAP) { atomicAdd(&bar[XB_TMO], 1u); break; } }
    }
    nloc = mine > 0u ? mine : 1u; nx = cnt > 0u ? cnt : 1u;
}

__device__ __forceinline__ void xcd_barrier(const XcdBarrier& b) {
    asm volatile("s_waitcnt vmcnt(0)" ::: "memory");
    __syncthreads();
    if (threadIdx.x == 0) {
        unsigned* bar = b.bar;
        __builtin_amdgcn_s_waitcnt(0);
        unsigned nloc = b.st[0], nx = b.st[1];
        if (nloc == 0u) { xcd_barrier_complete(bar, b.x, nloc, nx); b.st[0] = nloc; b.st[1] = nx; }
        const unsigned old = xb_add(&bar[XB_XSUB(b.x)], 1u);
        const unsigned gen = old / nloc;
        if (old + 1u == (gen + 1u) * nloc) {
            __builtin_amdgcn_fence(__ATOMIC_RELEASE, "agent");
            asm volatile("s_waitcnt vmcnt(0)" ::: "memory");
            const unsigned og = xb_add(&bar[XB_TOP], 1u);
            const unsigned tg = og / nx;
            if (og + 1u == (tg + 1u) * nx) xb_add(&bar[XB_TOPGEN], 1u);
            else XB_SPIN(xb_ld(&bar[XB_TOPGEN]) == tg, bar);
            __builtin_amdgcn_fence(__ATOMIC_ACQUIRE, "agent");
            xb_add(&bar[XB_XGEN(b.x)], 1u);
            asm volatile("s_waitcnt vmcnt(0)" ::: "memory");
        } else {
            XB_SPIN(xb_ld(&bar[XB_XGEN(b.x)]) == gen, bar);
            __builtin_amdgcn_fence(__ATOMIC_ACQUIRE, "agent");
            asm volatile("s_waitcnt vmcnt(0)" ::: "memory");
        }
    }
    __syncthreads();
}

__device__ __forceinline__ void xcd_barrier_arrive(const XcdBarrier& b, bool publish = true) {
    asm volatile("s_waitcnt vmcnt(0)" ::: "memory");
    __syncthreads();
    if (threadIdx.x == 0) {
        unsigned* bar = b.bar;
        __builtin_amdgcn_s_waitcnt(0);
        unsigned nloc = b.st[0], nx = b.st[1];
        if (nloc == 0u) { xcd_barrier_complete(bar, b.x, nloc, nx); b.st[0] = nloc; b.st[1] = nx; }
        const unsigned old = xb_add(&bar[XB_XSUB(b.x)], 1u);
        const unsigned gen = old / nloc;
        if (old + 1u == (gen + 1u) * nloc) {
            if (publish) { __builtin_amdgcn_fence(__ATOMIC_RELEASE, "agent"); asm volatile("s_waitcnt vmcnt(0)" ::: "memory"); }
            const unsigned og = xb_add(&bar[XB_TOP], 1u);
            const unsigned tg = og / nx;
            if (og + 1u == (tg + 1u) * nx) xb_add(&bar[XB_TOPGEN], 1u);
            b.st[2] = 1u; b.st[3] = tg;
        } else { b.st[2] = 0u; b.st[3] = gen; }
    }
}
__device__ __forceinline__ void xcd_barrier_wait(const XcdBarrier& b, bool acq = true) {
    if (threadIdx.x == 0) {
        unsigned* bar = b.bar; const unsigned g = b.st[3];
        if (b.st[2]) { XB_SPIN(xb_ld(&bar[XB_TOPGEN]) == g, bar); if (acq) __builtin_amdgcn_fence(__ATOMIC_ACQUIRE, "agent"); xb_add(&bar[XB_XGEN(b.x)], 1u); asm volatile("s_waitcnt vmcnt(0)" ::: "memory"); }
        else { XB_SPIN(xb_ld(&bar[XB_XGEN(b.x)]) == g, bar); if (acq) { __builtin_amdgcn_fence(__ATOMIC_ACQUIRE, "agent"); asm volatile("s_waitcnt vmcnt(0)" ::: "memory"); } }
    }
    __syncthreads();
}

__device__ __forceinline__ void quad_barrier(unsigned* cnt, unsigned* tmo, unsigned same_xcd) {
    asm volatile("s_waitcnt vmcnt(0)" ::: "memory");
    __syncthreads();
    if (threadIdx.x == 0) {
        if (!same_xcd) { __builtin_amdgcn_fence(__ATOMIC_RELEASE, "agent"); asm volatile("s_waitcnt vmcnt(0)" ::: "memory"); }
        const unsigned old = xb_add(cnt, 1u);
        const unsigned target = (old / 4u + 1u) * 4u;
        XB_SPIN(xb_ld(cnt) < target, tmo);
        __builtin_amdgcn_fence(__ATOMIC_ACQUIRE, "agent");
        asm volatile("s_waitcnt vmcnt(0)" ::: "memory");
    }
    __syncthreads();
}

__device__ __forceinline__ void group_barrier(unsigned* cnt, unsigned* tmo, unsigned same, unsigned n) {
    asm volatile("s_waitcnt vmcnt(0)" ::: "memory");
    __syncthreads();
    if (threadIdx.x == 0) {
        if (!same) { __builtin_amdgcn_fence(__ATOMIC_RELEASE, "agent"); asm volatile("s_waitcnt vmcnt(0)" ::: "memory"); }
        const unsigned old = xb_add(cnt, 1u);
        const unsigned target = (old / n + 1u) * n;
        XB_SPIN(xb_ld(cnt) < target, tmo);
        __builtin_amdgcn_fence(__ATOMIC_ACQUIRE, "agent");
        asm volatile("s_waitcnt vmcnt(0)" ::: "memory");
    }
    __syncthreads();
}
__device__ __forceinline__ void group_arrive(unsigned* cnt, unsigned same, unsigned n, volatile LAS unsigned* st) {
    asm volatile("s_waitcnt vmcnt(0)" ::: "memory");
    __syncthreads();
    if (threadIdx.x == 0) {
        if (!same) { __builtin_amdgcn_fence(__ATOMIC_RELEASE, "agent"); asm volatile("s_waitcnt vmcnt(0)" ::: "memory"); }
        const unsigned old = xb_add(cnt, 1u);
        st[0] = (old / n + 1u) * n;
    }
}
__device__ __forceinline__ void group_wait(unsigned* cnt, unsigned* tmo, volatile LAS unsigned* st, bool acq = true) {
    if (threadIdx.x == 0) {
        const unsigned target = st[0];
        XB_SPIN(xb_ld(cnt) < target, tmo);
        if (acq) { __builtin_amdgcn_fence(__ATOMIC_ACQUIRE, "agent"); asm volatile("s_waitcnt vmcnt(0)" ::: "memory"); }
    }
    __syncthreads();
}
#ifndef CFG_ALIGN
#define CFG_ALIGN true
#endif
#ifndef CFG_ALIGN1
#define CFG_ALIGN1 true
#endif
#ifndef CFG_SP2
#define CFG_SP2 true
#endif
#ifndef PROBE_MASK
#define PROBE_MASK 0
#endif
constexpr size_t MiB = 1u << 20;
constexpr size_t WS_CTL = 0, CTL_ZERO_BYTES = 3 * MiB, WS_SSQ = 1 * MiB, WS_WLR = 2 * MiB + 512 * 1024;
constexpr size_t WS_WIN = 3 * MiB, WS_WBR = 14 * MiB, WS_WO = 16 * MiB, WS_WUP = 18 * MiB, WS_WDN = 26 * MiB;
constexpr size_t WS_XN = 35 * MiB, WS_PROJ = 67 * MiB, WS_DSS = 243 * MiB, WS_DT = 251 * MiB, WS_OI = 259 * MiB, WS_END = 291 * MiB;
static_assert(WS_WIN - WS_WLR == WOF_IN * 2 && WS_WBR - WS_WLR == WOF_BR * 2 && WS_WO - WS_WLR == WOF_O * 2 && WS_WUP - WS_WLR == WOF_UP * 2 && WS_WDN - WS_WLR == WOF_DN * 2, "weight offsets");
static_assert((size_t)NIN * DM * 2 <= WS_WBR - WS_WIN && (size_t)M * DM * 2 <= WS_PROJ - WS_XN && (size_t)(M / 256) * PBE * 2 <= WS_DSS - WS_PROJ && 256 * LDH <= PBE && (size_t)NUNIT * 8192 * 2 <= WS_DT - WS_DSS && (size_t)NUNIT * 64 * 4 <= WS_OI - WS_DT && (size_t)NITEM * 8192 * 4 <= WS_END - WS_OI && (size_t)9 * M * 8 <= 2 * MiB && WS_WDN + (size_t)DM * LDH * 2 <= WS_XN, "d_ws map");
constexpr int CW_BAR = 4096;
constexpr int CW_QUAD = 16384, CW_XCC = 32768, CW_BATCH = 24576;
constexpr int RS_OFF = 131072;
constexpr int RING_BYTES = 147456, MISC_OFF = RING_BYTES + 320, LDS_BYTES = RING_BYTES + 1024;
static_assert(ATT_END <= RING_BYTES && GA_END <= RING_BYTES && GB_END <= RING_BYTES && LR_END <= RING_BYTES && pg8::STAGE_BYTES <= RING_BYTES && NW * CONV_SCR <= RING_BYTES, "LDS map");

struct InOrder {
    pg8::StaticOrder so; int late, ident;
    __device__ __forceinline__ bool next(int i, pg8::Unit& u) const { if (ident) return so.next(i, u); if (i >= 5) return false; const int r = i == 0 ? 3 : i == 1 ? 4 : i == 2 ? 0 : (i == 3 ? (late ? 2 : 1) : (late ? 1 : 2)); return so.next(r, u); }
    __device__ __forceinline__ void a_ready(const pg8::Unit&) const {}
    __device__ __forceinline__ void done(const pg8::Unit&) const {}
};
struct MergeOrder {
    pg8::StaticOrder so;
    __device__ __forceinline__ bool next(int i, pg8::Unit& u) const { pg8::Unit v; if (!so.next(i >> 1, v)) return false; const int br = i & 1; u.pm = v.pm + br * (M / 256); u.pn = v.pn + br * 4; return true; }
    __device__ __forceinline__ void a_ready(const pg8::Unit&) const {}
    __device__ __forceinline__ void done(const pg8::Unit&) const {}
};

__device__ __forceinline__ int lane_id() { int l; asm volatile("v_mbcnt_lo_u32_b32 %0, -1, 0\n\tv_mbcnt_hi_u32_b32 %0, -1, %0" : "=v"(l)); return l; }
struct Args { const float* in[13]; float* out; unsigned char* ws; };

__global__ void __launch_bounds__(NT, 2) mega_fwd(Args a) {
    extern __shared__ __attribute__((aligned(16))) unsigned char lds_raw[];
    LAS unsigned char* lds = (LAS unsigned char*)lds_raw;
    const int tid0 = threadIdx.x, lane0 = tid0 & 63, wave = __builtin_amdgcn_readfirstlane(tid0 >> 6);
    const int G = gridDim.x, bx0 = blockIdx.x, vcu0 = (G % 8 == 0) ? (bx0 % 8) * (G / 8) + bx0 / 8 : bx0;
    const int ngw = G * NW;
    for (int u = tid0; u < (LDS_BYTES - RING_BYTES) / 4; u += NT) ((LAS unsigned*)(lds + RING_BYTES))[u] = 0u;
    __syncthreads();
    unsigned char* ws = a.ws;
    Ptrs P;
    P.x = a.in[0]; P.mix_g = a.in[1]; P.w_in = a.in[2]; P.relb = a.in[3]; P.wglr = a.in[4]; P.bgate = a.in[5]; P.gng = a.in[6]; P.wbr = a.in[7]; P.wout = a.in[8]; P.mlp_g = a.in[9]; P.wup = a.in[10]; P.wdn = a.in[11]; P.fin_g = a.in[12];
    P.res = a.out;
    P.wts = (bf16_t*)(ws + WS_WLR); P.XN = (bf16_t*)(ws + WS_XN); P.proj = (bf16_t*)(ws + WS_PROJ);
    P.DSS = (bf16_t*)(ws + WS_DSS); P.DT = (float*)(ws + WS_DT); P.OI = (float*)(ws + WS_OI); P.SSQ = (unsigned long long*)(ws + WS_SSQ);
    XcdBarrier bar = xcd_barrier_post((unsigned*)(ws + WS_CTL) + CW_BAR, (volatile LAS unsigned*)(lds + MISC_OFF) + 8);
    LAS float* scr = (LAS float*)(lds + wave * CONV_SCR);
    unsigned* ctlw = (unsigned*)(ws + WS_CTL);
    const int pm0 = 8 * (bx0 % 8) + (bx0 / 8) % 8, pn0 = bx0 / 64;
    const bool quad_ok = (G == 256);
    if (tid0 == 0) __hip_atomic_store(ctlw + CW_XCC + bx0, bar.x + 1u, __ATOMIC_RELAXED, __HIP_MEMORY_SCOPE_AGENT);
    volatile LAS unsigned* qflag = (volatile LAS unsigned*)(lds + MISC_OFF) + 16;

    if (PROBE_MASK & 128) phase_x0(P, vcu0 * NW + wave, ngw, lane0);
    phase_x0(P, vcu0 * NW + wave, ngw, lane0);
    conv_phase(P, -1, 0, scr, vcu0 * NW + wave, ngw, lane0);
    xcd_barrier(bar);
    if (tid0 == 0) { unsigned same = quad_ok ? 1u : 0u; const unsigned me = __hip_atomic_load(ctlw + CW_XCC + bx0, __ATOMIC_RELAXED, __HIP_MEMORY_SCOPE_AGENT);
        for (int q = 0; q < 4; ++q) if (__hip_atomic_load(ctlw + CW_XCC + (bx0 % 64) + 64 * q, __ATOMIC_RELAXED, __HIP_MEMORY_SCOPE_AGENT) != me) same = 0u;
        unsigned sameb = quad_ok ? 1u : 0u;
        for (int q = 0; q < 32; ++q) if (__hip_atomic_load(ctlw + CW_XCC + (bx0 % 8) + 8 * q, __ATOMIC_RELAXED, __HIP_MEMORY_SCOPE_AGENT) != me) sameb = 0u;
        qflag[0] = same; qflag[1] = sameb; }
    __syncthreads();
    const unsigned same_xcd = qflag[0], same_batch = qflag[1];
    unsigned* bcnt = ctlw + CW_BATCH + 64 * (bx0 % 8);
    volatile LAS unsigned* bst = (volatile LAS unsigned*)(lds + MISC_OFF) + 20;
    unsigned* qcnt = ctlw + CW_QUAD + 64 * pm0; unsigned* qtmo = (unsigned*)(ws + WS_CTL) + CW_BAR;
#define SEAM(q) do { if ((q) && quad_ok) quad_barrier(qcnt, qtmo, same_xcd); else xcd_barrier(bar); } while (0)
#pragma unroll 1
    for (int l = 0; l < DEPTH; ++l) {
        int bx = bx0, vcu = vcu0, lane = lane_id(), pm = pm0, pn = pn0; OPAQUE_S(bx); OPAQUE_S(vcu); OPAQUE_V(lane); OPAQUE_S(pm); OPAQUE_S(pn);
        const int gw = vcu * NW + wave;
        {
            if (quad_ok) { if (PROBE_MASK & 8192) lr_item(P, l, lds, 4 * pm + pn); lr_item(P, l, lds, 4 * pm + pn); }
            else for (int u = vcu; u < BATCH * NCH; u += G) lr_item(P, l, lds, u);
            pg8::Gemm g{P.XN, P.Win_t(), M, NIN, DM, DM, DM, (size_t)256 * DM * 2, 1 << 30, 0}; InOrder S; S.so.init(M, NIN, G, bx); S.late = pn >= 2; S.ident = quad_ok ? 0 : 1;
            pg8::Unit u0; S.so.next(0, u0); LAS float* rsl = (LAS float*)(lds + RS_OFF);
            int tid1 = wave * 64 + lane_id(); OPAQUE_V(tid1);
            if (tid1 < 256) rsl[tid1] = ssq_rstd(P.SSQ[(size_t)(2 * l) * M + u0.pm * 256 + tid1]);
            __syncthreads();
            EpiIn E{P, P.SSQ + (size_t)(2 * l) * M, rsl, u0.pm};
            pg8::gemm_phase<EpiIn, InOrder, CFG_ALIGN, CFG_SP2>(lds, g, S, E);
        }
        if (quad_ok) { xcd_barrier_arrive(bar, same_batch == 0u); group_barrier(bcnt, qtmo, same_batch, 32u); }
        else xcd_barrier(bar);
        {
            if (quad_ok) { if (PROBE_MASK & 2) gla_a_unit<false>(P, lds, (((pm >> 3) * 4 + pn) * NSC) + (pm & 7)); gla_a_unit(P, lds, (((pm >> 3) * 4 + pn) * NSC) + (pm & 7)); }
            else for (int u = vcu; u < NUNIT; u += G) gla_a_unit(P, lds, u);
            if (quad_ok) xcd_barrier_wait(bar, false);
            if (PROBE_MASK & 8) conv_phase(P, l, l + 1, scr, gw, ngw, lane);
            conv_phase(P, l, l + 1, scr, gw, ngw, lane);
            xcd_barrier_arrive(bar);
            if (quad_ok) { for (int hg = 0; hg < 2; ++hg) { if (PROBE_MASK & 4) att_unit<false>(P, l, lds, pm >> 3, 4 * (pm & 7) + pn, hg); att_unit(P, l, lds, pm >> 3, 4 * (pm & 7) + pn, hg); } }
            else for (int u = vcu; u < BATCH * NCH * 2; u += G) { const int c = u % NCH, bh = u / NCH; att_unit(P, l, lds, bh >> 1, c, bh & 1); }
            xcd_barrier_wait(bar);
            if (quad_ok) group_arrive(bcnt, same_batch, 32u, bst); else xcd_barrier_arrive(bar);
            if (quad_ok) { if (PROBE_MASK & 16) gla_b_unit(P, l, lds, (((pm >> 3) * 4 + pn) * NSC) + (pm & 7)); gla_b_unit(P, l, lds, (((pm >> 3) * 4 + pn) * NSC) + (pm & 7)); }
            else for (int u = vcu; u < NUNIT; u += G) gla_b_unit(P, l, lds, u);
            if (quad_ok) group_wait(bcnt, qtmo, bst, false); else xcd_barrier_wait(bar);
        }
        SEAM(1);
        {
            pg8::Gemm g{P.QA(), P.Wbr_t(), 2 * M, 2048, 512, 512, 512, (size_t)PBE * 2, M / 256, (size_t)(O_VB - O_QA) * 2};     MergeOrder S; S.so.init(M, DM, G, bx);
            EpiMerge E{P};
            if (PROBE_MASK & 32) { pg8::gemm_phase<EpiMerge, MergeOrder, CFG_ALIGN, CFG_SP2>(lds, g, S, E); __syncthreads(); }
            pg8::gemm_phase<EpiMerge, MergeOrder, CFG_ALIGN, CFG_SP2>(lds, g, S, E);
        }
        SEAM(1);
        {
            pg8::Gemm g{P.MERGED(), P.Wo_t(), M, DM, DM, DM, DM, (size_t)PBE * 2, 1 << 30, 0}; pg8::StaticOrder S; S.init(M, DM, G, bx);
            EpiRes E{P, P.SSQ + (size_t)(2 * l + 1) * M};
            pg8::gemm_phase<EpiRes, pg8::StaticOrder, CFG_ALIGN1, CFG_SP2>(lds, g, S, E);
        }
        SEAM(1);
        {
            pg8::Gemm g{P.XN, P.Wup_t(), M, DFF, DM, DM, DM, (size_t)256 * DM * 2, 1 << 30, 0}; pg8::StaticOrder S; S.init(M, DFF, G, bx);
            pg8::Unit u0; S.next(0, u0); LAS float* rsl = (LAS float*)(lds + RS_OFF);
            int tid5 = wave * 64 + lane_id(); OPAQUE_V(tid5);
            if (tid5 < 256) rsl[tid5] = ssq_rstd(P.SSQ[(size_t)(2 * l + 1) * M + u0.pm * 256 + tid5]);
            __syncthreads();
            EpiUp E{P, P.SSQ + (size_t)(2 * l + 1) * M, rsl, u0.pm};
            if (PROBE_MASK & 64) { pg8::gemm_phase<EpiUp, pg8::StaticOrder, CFG_ALIGN, CFG_SP2>(lds, g, S, E); __syncthreads(); }
            pg8::gemm_phase<EpiUp, pg8::StaticOrder, CFG_ALIGN, CFG_SP2>(lds, g, S, E);
        }
        SEAM(1);
        {
            pg8::Gemm g{P.HID(), P.Wdn_t(), M, DM, DFF, LDH, LDH, (size_t)PBE * 2, 1 << 30, 0}; pg8::StaticOrder S; S.init(M, DM, G, bx);
            EpiRes E{P, P.SSQ + (size_t)(2 * l + 2) * M};
            pg8::gemm_phase<EpiRes, pg8::StaticOrder, CFG_ALIGN1, CFG_SP2>(lds, g, S, E);
        }
        SEAM(1);
    }
    int lane_f = lane_id(), pmf = pm0; OPAQUE_V(lane_f); OPAQUE_S(pmf);
    if (quad_ok) phase_final(P, pmf * 256 + pn0 * 64 + wave, pmf * 256 + pn0 * 64 + 64, NW, lane_f);
    else phase_final(P, vcu0 * NW + wave, M, ngw, lane_f);
#undef SEAM
}

extern "C" void kernel_launch(void* const* d_in, const int* in_sizes, int n_in, void* d_out, int out_size, void* d_ws, size_t ws_size, hipStream_t stream) {
    static int grid = 0;
    if (grid == 0) {
        if (n_in != 13 || out_size != M * DM || ws_size < WS_END) { fprintf(stderr, "kernel_launch: unexpected shapes (n_in %d, out %d, ws %zu < %zu)\n", n_in, out_size, ws_size, (size_t)WS_END); grid = -1; return; }
        int dev = 0, cus = 0, per_cu = 0;
        if (hipGetDevice(&dev) != hipSuccess || hipDeviceGetAttribute(&cus, hipDeviceAttributeMultiprocessorCount, dev) != hipSuccess) { grid = -1; return; }
        if (hipFuncSetAttribute((const void*)mega_fwd, hipFuncAttributeMaxDynamicSharedMemorySize, LDS_BYTES) != hipSuccess) { fprintf(stderr, "kernel_launch: hipFuncSetAttribute failed\n"); grid = -1; return; }
        if (hipOccupancyMaxActiveBlocksPerMultiprocessor(&per_cu, (const void*)mega_fwd, NT, LDS_BYTES) != hipSuccess || per_cu < 1) fprintf(stderr, "kernel_launch: occupancy query says %d blocks/CU\n", per_cu);
        (void)hipGetLastError();
        grid = cus;
    }
    if (grid < 0) return;
    (void)hipMemsetAsync((char*)d_ws + WS_CTL, 0, CTL_ZERO_BYTES, stream);
    Args a{};
    for (int i = 0; i < 13; ++i) a.in[i] = (const float*)d_in[i];
    a.out = (float*)d_out; a.ws = (unsigned char*)d_ws;
    hipLaunchKernelGGL(mega_fwd, dim3(grid), dim3(NT), LDS_BYTES, stream, a);
}
```
